# Optimizing an MI355X kernel written in HIP

```python
import math
import jax, jax.numpy as jnp
from jax import lax
import numpy as np

D_MODEL = 1024
BATCH = 2
SEQ = 8192
DEPTH = 4

GRID_W = 64
CTX_LEN = 256
HEAD_DIM = 64
BLOCK = 128
EPS = 1e-6
ROPE_BASE = 10000.0
DIFF_HEADS = 4
DIFF_V = 2 * HEAD_DIM
SWA_Q_HEADS = 8
SWA_KV_HEADS = 2
SWA_GROUP = SWA_Q_HEADS // SWA_KV_HEADS
WINDOW = 128
MLA_HEADS = 8
MLA_Q_LORA = 512
MLA_KV_LORA = 256
MLA_NOPE = 64
MLA_ROPE = 32
MLA_QK = MLA_NOPE + MLA_ROPE
MLA_V = 64
NA_HEADS = 8
NA_ROWS_MAX = 8
NA_COLS = 16
D_FF = 4 * D_MODEL
N_EVEN = (DEPTH + 1) // 2
N_ODD = DEPTH // 2
EVEN_SPLITS = (DIFF_HEADS * 2 * HEAD_DIM, DIFF_HEADS * 2 * HEAD_DIM, DIFF_HEADS * DIFF_V,
               SWA_Q_HEADS * HEAD_DIM, SWA_KV_HEADS * HEAD_DIM, SWA_KV_HEADS * HEAD_DIM)
ODD_SPLITS = (MLA_Q_LORA, MLA_KV_LORA, MLA_ROPE,
              NA_HEADS * HEAD_DIM, NA_HEADS * HEAD_DIM, NA_HEADS * HEAD_DIM)
EVEN_IN = sum(EVEN_SPLITS)
ODD_IN = sum(ODD_SPLITS)
MIX_OUT = DIFF_HEADS * DIFF_V + SWA_Q_HEADS * HEAD_DIM

kernel_name = 'hybrid_diffusion_prefix_trunk'


def rmsnorm(x, g):
    xf = x.astype(jnp.float32)
    y = xf * lax.rsqrt(jnp.mean(xf * xf, axis=-1, keepdims=True) + EPS)
    return (y * g.astype(jnp.float32)).astype(x.dtype)


def modulate(x, g, shift, scale):
    return rmsnorm(x, g) * (1.0 + scale) + shift


def split_cols(p, sizes):
    idx = [int(i) for i in np.cumsum(sizes)[:-1]]
    return jnp.split(p, idx, axis=-1)


def axial_rope_tables(n_tokens, rot_dim):
    t = jnp.arange(n_tokens, dtype=jnp.int32)
    row = (t // GRID_W).astype(jnp.float32)
    col = (t % GRID_W).astype(jnp.float32)
    n_freq = rot_dim // 4
    freqs = jnp.power(ROPE_BASE, -jnp.arange(n_freq, dtype=jnp.float32) / n_freq)
    ar = row[:, None] * freqs[None, :]
    ac = col[:, None] * freqs[None, :]
    ang = jnp.concatenate([ar, ar, ac, ac], axis=-1)
    return jnp.cos(ang), jnp.sin(ang)


def rope_2d(x, cos, sin):
    shape = (1, x.shape[1]) + (1,) * (x.ndim - 3) + (x.shape[-1],)
    x1, x2, x3, x4 = jnp.split(x, 4, axis=-1)
    rot = jnp.concatenate([-x2, x1, -x4, x3], axis=-1)
    return (x * cos.reshape(shape) + rot * sin.reshape(shape)).astype(x.dtype)


def sweep_query_blocks(fn, *qs):
    B, S = qs[0].shape[:2]
    nb = S // BLOCK
    blocks = tuple(jnp.moveaxis(q.reshape((B, nb, BLOCK) + q.shape[2:]), 1, 0) for q in qs)
    out = lax.map(lambda a: fn(*a), blocks)
    return jnp.moveaxis(out, 0, 1).reshape((B, S) + out.shape[3:])


def mha_attend(q, k, v, bias=None, mask=None):
    s = jnp.einsum('bqhd,bkhd->bhqk', q, k).astype(jnp.float32) * (q.shape[-1] ** -0.5)
    if bias is not None:
        s = s + bias[None]
    if mask is not None:
        s = jnp.where(mask, s, -jnp.inf)
    p = jax.nn.softmax(s, axis=-1)
    return jnp.einsum('bhqk,bkhd->bqhd', p.astype(v.dtype), v)


def diff_attend(q, k, v, lam):
    s = jnp.einsum('bqhtd,bkhtd->bthqk', q, k).astype(jnp.float32) * (q.shape[-1] ** -0.5)
    a = jax.nn.softmax(s, axis=-1)
    p = a[:, 0] - lam * a[:, 1]
    return jnp.einsum('bhqk,bkhe->bqhe', p.astype(v.dtype), v)


def gqa_sink_attend(q, k, v, sink, mask=None):
    s = jnp.einsum('bqhgd,bkhd->bhgqk', q, k).astype(jnp.float32) * (q.shape[-1] ** -0.5)
    if mask is not None:
        s = jnp.where(mask, s, -jnp.inf)
    sk = sink.astype(jnp.float32)[None, :, :, None, None]
    m = jnp.maximum(jnp.max(s, axis=-1, keepdims=True), sk)
    e = jnp.exp(s - m)
    p = e / (jnp.sum(e, axis=-1, keepdims=True) + jnp.exp(sk - m))
    return jnp.einsum('bhgqk,bkhd->bqhgd', p.astype(v.dtype), v)


def window_gqa(q, k, v, kc, vc, sink):
    B, S = q.shape[:2]
    nb = S // BLOCK
    L = kc.shape[1]

    def band(t):
        tp = jnp.pad(t, ((0, 0), (BLOCK, BLOCK), (0, 0), (0, 0))).reshape((B, nb + 2, BLOCK) + t.shape[2:])
        strip = jnp.concatenate([tp[:, :-2], tp[:, 1:-1], tp[:, 2:]], axis=2)
        return jnp.moveaxis(strip, 1, 0)

    qb = jnp.moveaxis(q.reshape((B, nb, BLOCK) + q.shape[2:]), 1, 0)
    qi = jnp.arange(BLOCK)[:, None]
    kj = jnp.arange(3 * BLOCK)[None, :] - BLOCK
    ctx_mask = jnp.ones((BLOCK, L), dtype=bool)

    def blk(args):
        n, qn, kn, vn = args
        pos_k = n * BLOCK + kj
        m = (jnp.abs(kj - qi) <= WINDOW) & (pos_k >= 0) & (pos_k < S)
        m = jnp.concatenate([m, ctx_mask], axis=1)
        kk = jnp.concatenate([kn, kc], axis=1)
        vv = jnp.concatenate([vn, vc], axis=1)
        return gqa_sink_attend(qn, kk, vv, sink, m)

    out = lax.map(blk, (jnp.arange(nb), qb, band(k), band(v)))
    return jnp.moveaxis(out, 0, 1).reshape(B, S, -1)


def neighbourhood_attn(q, k, v, kc, vc, rpb):
    B, S, H, d = q.shape
    rows = S // GRID_W
    kr = min(NA_ROWS_MAX, rows)
    L = kc.shape[1]
    qg = jnp.moveaxis(q.reshape(B, rows, GRID_W, H, d), 1, 0)
    kg = k.reshape(B, rows, GRID_W, H, d)
    vg = v.reshape(B, rows, GRID_W, H, d)
    cq = jnp.arange(GRID_W)
    cs = jnp.clip(cq - NA_COLS // 2, 0, GRID_W - NA_COLS)
    ck = jnp.arange(GRID_W)
    col_mask = (ck[None, :] >= cs[:, None]) & (ck[None, :] < cs[:, None] + NA_COLS)
    nb_mask = jnp.broadcast_to(col_mask[:, None, :], (GRID_W, kr, GRID_W)).reshape(GRID_W, kr * GRID_W)
    mask = jnp.concatenate([nb_mask, jnp.ones((GRID_W, L), dtype=bool)], axis=1)
    dc_idx = jnp.clip(ck[None, :] - cq[:, None], -(NA_COLS - 1), NA_COLS - 1) + NA_COLS - 1
    rpb32 = rpb.astype(jnp.float32)

    def row_block(args):
        r, qr = args
        rs = jnp.clip(r - kr // 2, 0, rows - kr)
        krows = lax.dynamic_slice_in_dim(kg, rs, kr, axis=1).reshape(B, kr * GRID_W, H, d)
        vrows = lax.dynamic_slice_in_dim(vg, rs, kr, axis=1).reshape(B, kr * GRID_W, H, d)
        dr_idx = rs + jnp.arange(kr) - r + NA_ROWS_MAX - 1
        bias = rpb32[:, dr_idx[None, :, None], dc_idx[:, None, :]].reshape(H, GRID_W, kr * GRID_W)
        bias = jnp.pad(bias, ((0, 0), (0, 0), (0, L)))
        kk = jnp.concatenate([krows, kc], axis=1)
        vv = jnp.concatenate([vrows, vc], axis=1)
        return mha_attend(qr, kk, vv, bias, mask)

    out = lax.map(row_block, (jnp.arange(rows), qg))
    return jnp.moveaxis(out, 0, 1).reshape(B, S, H * d)


def even_mixer(p_lat, p_ctx, q_g, k_g, lam_v, subln_g, sq_g, sk_g, sink, cos, sin, lam_init, need_ctx):
    def project(p, rope):
        B, N, _ = p.shape
        qa, ka, va, qb, kb, vb = split_cols(p, EVEN_SPLITS)
        qa = rmsnorm(qa.reshape(B, N, DIFF_HEADS, 2, HEAD_DIM), q_g)
        ka = rmsnorm(ka.reshape(B, N, DIFF_HEADS, 2, HEAD_DIM), k_g)
        va = va.reshape(B, N, DIFF_HEADS, DIFF_V)
        qb = rmsnorm(qb.reshape(B, N, SWA_KV_HEADS, SWA_GROUP, HEAD_DIM), sq_g)
        kb = rmsnorm(kb.reshape(B, N, SWA_KV_HEADS, HEAD_DIM), sk_g)
        vb = vb.reshape(B, N, SWA_KV_HEADS, HEAD_DIM)
        if rope:
            qa, ka, qb, kb = [rope_2d(t, cos, sin) for t in (qa, ka, qb, kb)]
        return qa, ka, va, qb, kb, vb

    qa_l, ka_l, va_l, qb_l, kb_l, vb_l = project(p_lat, True)
    qa_c, ka_c, va_c, qb_c, kb_c, vb_c = project(p_ctx, False)
    lv = lam_v.astype(jnp.float32)
    lam = jnp.exp(jnp.sum(lv[0] * lv[1])) - jnp.exp(jnp.sum(lv[2] * lv[3])) + lam_init
    sink_hg = sink.reshape(SWA_KV_HEADS, SWA_GROUP)

    def diff_out(o):
        B, N = o.shape[:2]
        return (rmsnorm(o, subln_g) * (1.0 - lam_init)).reshape(B, N, DIFF_HEADS * DIFF_V)

    ka_all = jnp.concatenate([ka_l, ka_c], axis=1)
    va_all = jnp.concatenate([va_l, va_c], axis=1)
    o_a = sweep_query_blocks(lambda qblk: diff_attend(qblk, ka_all, va_all, lam), qa_l)
    o_b = window_gqa(qb_l, kb_l, vb_l, kb_c, vb_c, sink_hg)
    o_lat = jnp.concatenate([diff_out(o_a), o_b], axis=-1)
    if not need_ctx:
        return o_lat, None
    B, L = p_ctx.shape[:2]
    o_ca = diff_out(diff_attend(qa_c, ka_c, va_c, lam))
    o_cb = gqa_sink_attend(qb_c, kb_c, vb_c, sink_hg).reshape(B, L, -1)
    return o_lat, jnp.concatenate([o_ca, o_cb], axis=-1)


def odd_mixer(p_lat, p_ctx, qa_g, kva_g, wq_up, wkv_up, mq_g, mk_g, nq_g, nk_g, rpb, cos, sin, need_ctx):
    def project(p, rope):
        B, N, _ = p.shape
        q_a, kv_a, k_r, nq, nk, nv = split_cols(p, ODD_SPLITS)
        q = (rmsnorm(q_a, qa_g) @ wq_up).reshape(B, N, MLA_HEADS, MLA_QK)
        kv = (rmsnorm(kv_a, kva_g) @ wkv_up).reshape(B, N, MLA_HEADS, MLA_NOPE + MLA_V)
        k = jnp.concatenate([kv[..., :MLA_NOPE],
                             jnp.broadcast_to(k_r[:, :, None, :], (B, N, MLA_HEADS, MLA_ROPE))], axis=-1)
        v = kv[..., MLA_NOPE:]
        q = rmsnorm(q, mq_g)
        k = rmsnorm(k, mk_g)
        if rope:
            q = jnp.concatenate([q[..., :MLA_NOPE], rope_2d(q[..., MLA_NOPE:], cos, sin)], axis=-1)
            k = jnp.concatenate([k[..., :MLA_NOPE], rope_2d(k[..., MLA_NOPE:], cos, sin)], axis=-1)
        nq = rmsnorm(nq.reshape(B, N, NA_HEADS, HEAD_DIM), nq_g)
        nk = rmsnorm(nk.reshape(B, N, NA_HEADS, HEAD_DIM), nk_g)
        nv = nv.reshape(B, N, NA_HEADS, HEAD_DIM)
        return q, k, v, nq, nk, nv

    q_l, k_l, v_l, nq_l, nk_l, nv_l = project(p_lat, True)
    q_c, k_c, v_c, nq_c, nk_c, nv_c = project(p_ctx, False)
    B, S = p_lat.shape[:2]
    k_all = jnp.concatenate([k_l, k_c], axis=1)
    v_all = jnp.concatenate([v_l, v_c], axis=1)
    o_c = sweep_query_blocks(lambda qblk: mha_attend(qblk, k_all, v_all), q_l).reshape(B, S, -1)
    o_d = neighbourhood_attn(nq_l, nk_l, nv_l, nk_c, nv_c, rpb)
    o_lat = jnp.concatenate([o_c, o_d], axis=-1)
    if not need_ctx:
        return o_lat, None
    L = p_ctx.shape[1]
    o_cc = mha_attend(q_c, k_c, v_c).reshape(B, L, -1)
    o_cd = mha_attend(nq_c, nk_c, nv_c).reshape(B, L, -1)
    return o_lat, jnp.concatenate([o_cc, o_cd], axis=-1)


def sq_relu_mlp(h, w1, w2):
    return jnp.square(jax.nn.relu(h @ w1)) @ w2


def setup_inputs(seed: int = 0) -> dict:
    key = jax.random.key(seed)
    ks = jax.random.split(key, 32)
    D = D_MODEL

    def nrm(k, shape, scale):
        return jax.random.normal(k, shape, jnp.float32) * scale

    def gain(k, shape):
        return 1.0 + 0.02 * jax.random.normal(k, shape, jnp.float32)

    return {
        'x': nrm(ks[0], (BATCH, SEQ, D), 1.0),
        'c': nrm(ks[1], (BATCH, D), 1.0),
        'ctx': nrm(ks[2], (BATCH, CTX_LEN, D), 1.0),
        'c_ctx': nrm(ks[3], (D,), 1.0),
        'ada_w': nrm(ks[4], (DEPTH, D, 6 * D), D ** -0.5),
        'ada_b': nrm(ks[5], (DEPTH, 6 * D), 0.02),
        'norm1_g': gain(ks[6], (DEPTH, D)),
        'norm2_g': gain(ks[7], (DEPTH, D)),
        'w_out': nrm(ks[8], (DEPTH, MIX_OUT, D), MIX_OUT ** -0.5),
        'mlp_w1': nrm(ks[9], (DEPTH, D, D_FF), D ** -0.5),
        'mlp_w2': nrm(ks[10], (DEPTH, D_FF, D), D_FF ** -0.5),
        'ev_w_in': nrm(ks[11], (N_EVEN, D, EVEN_IN), D ** -0.5),
        'diff_q_g': gain(ks[12], (N_EVEN, HEAD_DIM)),
        'diff_k_g': gain(ks[13], (N_EVEN, HEAD_DIM)),
        'diff_lam': nrm(ks[14], (N_EVEN, 4, HEAD_DIM), 0.1),
        'diff_subln_g': gain(ks[15], (N_EVEN, DIFF_V)),
        'swa_q_g': gain(ks[16], (N_EVEN, HEAD_DIM)),
        'swa_k_g': gain(ks[17], (N_EVEN, HEAD_DIM)),
        'swa_sink': nrm(ks[18], (N_EVEN, SWA_Q_HEADS), 0.5),
        'od_w_in': nrm(ks[19], (N_ODD, D, ODD_IN), D ** -0.5),
        'mla_qa_g': gain(ks[20], (N_ODD, MLA_Q_LORA)),
        'mla_kva_g': gain(ks[21], (N_ODD, MLA_KV_LORA)),
        'mla_wq_up': nrm(ks[22], (N_ODD, MLA_Q_LORA, MLA_HEADS * MLA_QK), MLA_Q_LORA ** -0.5),
        'mla_wkv_up': nrm(ks[23], (N_ODD, MLA_KV_LORA, MLA_HEADS * (MLA_NOPE + MLA_V)), MLA_KV_LORA ** -0.5),
        'mla_q_g': gain(ks[24], (N_ODD, MLA_QK)),
        'mla_k_g': gain(ks[25], (N_ODD, MLA_QK)),
        'na_q_g': gain(ks[26], (N_ODD, HEAD_DIM)),
        'na_k_g': gain(ks[27], (N_ODD, HEAD_DIM)),
        'na_rpb': nrm(ks[28], (N_ODD, NA_HEADS, 2 * NA_ROWS_MAX - 1, 2 * NA_COLS - 1), 0.2),
    }


def reference(x, c, ctx, c_ctx, ada_w, ada_b, norm1_g, norm2_g, w_out, mlp_w1, mlp_w2,
              ev_w_in, diff_q_g, diff_k_g, diff_lam, diff_subln_g, swa_q_g, swa_k_g, swa_sink,
              od_w_in, mla_qa_g, mla_kva_g, mla_wq_up, mla_wkv_up, mla_q_g, mla_k_g,
              na_q_g, na_k_g, na_rpb):
    S = x.shape[1]
    cos64, sin64 = axial_rope_tables(S, HEAD_DIM)
    cos32, sin32 = axial_rope_tables(S, MLA_ROPE)
    xc = ctx
    for layer in range(DEPTH):
        need_ctx = layer < DEPTH - 1
        mod_l = (jax.nn.silu(c) @ ada_w[layer] + ada_b[layer])[:, None, :]
        mod_c = (jax.nn.silu(c_ctx) @ ada_w[layer] + ada_b[layer])[None, None, :]
        sh1, sc1, g1, sh2, sc2, g2 = jnp.split(mod_l, 6, axis=-1)
        csh1, csc1, cg1, csh2, csc2, cg2 = jnp.split(mod_c, 6, axis=-1)
        h_l = modulate(x, norm1_g[layer], sh1, sc1)
        h_c = modulate(xc, norm1_g[layer], csh1, csc1)
        i = layer // 2
        if layer % 2 == 0:
            lam_init = 0.8 - 0.6 * math.exp(-0.3 * layer)
            o_l, o_c = even_mixer(h_l @ ev_w_in[i], h_c @ ev_w_in[i], diff_q_g[i], diff_k_g[i], diff_lam[i],
                                  diff_subln_g[i], swa_q_g[i], swa_k_g[i], swa_sink[i],
                                  cos64, sin64, lam_init, need_ctx)
        else:
            o_l, o_c = odd_mixer(h_l @ od_w_in[i], h_c @ od_w_in[i], mla_qa_g[i], mla_kva_g[i], mla_wq_up[i],
                                 mla_wkv_up[i], mla_q_g[i], mla_k_g[i], na_q_g[i], na_k_g[i], na_rpb[i],
                                 cos32, sin32, need_ctx)
        x = x + g1 * (o_l @ w_out[layer])
        x = x + g2 * sq_relu_mlp(modulate(x, norm2_g[layer], sh2, sc2), mlp_w1[layer], mlp_w2[layer])
        if need_ctx:
            xc = xc + cg1 * (o_c @ w_out[layer])
            xc = xc + cg2 * sq_relu_mlp(modulate(xc, norm2_g[layer], csh2, csc2), mlp_w1[layer], mlp_w2[layer])
    return x
```

```cpp
#include <hip/hip_runtime.h>
#include <hip/hip_cooperative_groups.h>
#include <cstdio>
#include <cmath>
namespace cg = cooperative_groups;

typedef unsigned short bf16_t;
typedef short bf16x8 __attribute__((ext_vector_type(8)));
typedef float f32x16 __attribute__((ext_vector_type(16)));
typedef float f32x4 __attribute__((ext_vector_type(4)));
typedef float f32x2 __attribute__((ext_vector_type(2)));
typedef unsigned u32x4 __attribute__((ext_vector_type(4)));
typedef unsigned u32x2 __attribute__((ext_vector_type(2)));
typedef __bf16 bf16v2 __attribute__((ext_vector_type(2)));
#define DI __device__ __forceinline__

constexpr int S_ = 8192, D_ = 1024, L_ = 256, NLAT = 2 * S_, NT = NLAT + 2 * L_, KV_ = S_ + L_;
constexpr int LDS_BYTES = 131072;
constexpr int NTHR = 512, NWV = 8;
constexpr float EPS_ = 1e-6f;
constexpr float LOG2E = 1.4426950408889634f;

DI unsigned pk2(float a, float b) { f32x2 v = {a, b}; bf16v2 r = __builtin_convertvector(v, bf16v2); return __builtin_bit_cast(unsigned, r); }
DI float lo2f(unsigned u) { return __uint_as_float(u << 16); }
DI float hi2f(unsigned u) { return __uint_as_float(u & 0xffff0000u); }
DI f32x16 mfma32(bf16x8 a, bf16x8 b, f32x16 c) { return __builtin_amdgcn_mfma_f32_32x32x16_bf16(a, b, c, 0, 0, 0); }
DI float ex2(float x) { return __builtin_amdgcn_exp2f(x); }

struct WJob { const float* src; bf16_t* dst; int K, N, Npad, tile0; int ntn, pad_; };

struct Params {
  const float *x, *c, *ctx, *c_ctx, *ada_w, *ada_b, *norm1_g, *norm2_g, *w_out, *mlp_w1, *mlp_w2,
      *ev_w_in, *diff_q_g, *diff_k_g, *diff_lam, *diff_subln_g, *swa_q_g, *swa_k_g, *swa_sink,
      *od_w_in, *mla_qa_g, *mla_kva_g, *mla_wq_up, *mla_wkv_up, *mla_q_g, *mla_k_g, *na_q_g, *na_k_g, *na_rpb;
  float* out;
  float* xc;
  float* mod;
  float* rope64;
  float* rope32;
  unsigned* bar;
  float* part;
  float* spill;
  bf16_t *wt_in[4], *wt_out[4], *wt_1[4], *wt_2[4], *wt_qup[2], *wt_kvup[2];
  bf16_t *H, *P, *HID, *Q1, *K1, *V1t, *Q2, *K2, *V2t, *QAn, *KVAn, *QUP, *KVUP, *KR;
  WJob jobs[22];
  int njobs, ntiles_w;
  float freq64[16], freq32[8], lam_init[4];
};

DI int tid_() { int t = threadIdx.x; asm volatile("" : "+v"(t)); return t; }
DI int bid_() { int b = blockIdx.x; asm volatile("" : "+s"(b)); return b; }
DI float wave_sum(float v) {
#pragma unroll
  for (int o = 32; o >= 1; o >>= 1) v += __shfl_xor(v, o);
  return v;
}
DI void sincos_d(float x, float& s, float& c) {
  double xd = (double)x;
  double n = rint(xd * 0.15915494309189535);
  double r = xd - n * 6.283185307179586477;
  double r2 = r * r;
  double sp = 1.0 / 51090942171709440000.0;
  sp = sp * (-r2) + 1.0 / 121645100408832000.0;
  sp = sp * (-r2) + 1.0 / 355687428096000.0;
  sp = sp * (-r2) + 1.0 / 1307674368000.0;
  sp = sp * (-r2) + 1.0 / 6227020800.0;
  sp = sp * (-r2) + 1.0 / 39916800.0;
  sp = sp * (-r2) + 1.0 / 362880.0;
  sp = sp * (-r2) + 1.0 / 5040.0;
  sp = sp * (-r2) + 1.0 / 120.0;
  sp = sp * (-r2) + 1.0 / 6.0;
  sp = sp * (-r2) + 1.0;
  double cp = 1.0 / 2432902008176640000.0;
  cp = cp * (-r2) + 1.0 / 6402373705728000.0;
  cp = cp * (-r2) + 1.0 / 20922789888000.0;
  cp = cp * (-r2) + 1.0 / 87178291200.0;
  cp = cp * (-r2) + 1.0 / 479001600.0;
  cp = cp * (-r2) + 1.0 / 3628800.0;
  cp = cp * (-r2) + 1.0 / 40320.0;
  cp = cp * (-r2) + 1.0 / 720.0;
  cp = cp * (-r2) + 1.0 / 24.0;
  cp = cp * (-r2) + 1.0 / 2.0;
  cp = cp * (-r2) + 1.0;
  s = (float)(r * sp);
  c = (float)cp;
}

DI void gbar(unsigned* bar, unsigned& gen) {
  asm volatile("s_waitcnt vmcnt(0)" ::: "memory");
  __syncthreads();
  ++gen;
  if (threadIdx.x == 0) {
    __builtin_amdgcn_fence(__ATOMIC_RELEASE, "agent");
    asm volatile("s_waitcnt vmcnt(0)" ::: "memory");
    __hip_atomic_fetch_add(bar, 1u, __ATOMIC_RELAXED, __HIP_MEMORY_SCOPE_AGENT);
    const unsigned target = gen * gridDim.x;
    while (__hip_atomic_load(bar, __ATOMIC_RELAXED, __HIP_MEMORY_SCOPE_AGENT) < target) __builtin_amdgcn_s_sleep(1);
    __builtin_amdgcn_fence(__ATOMIC_ACQUIRE, "agent");
    asm volatile("s_waitcnt vmcnt(0)" ::: "memory");
  }
  __syncthreads();
}

DI void row_bk(int row, int& b, int& kpos) {
  if (row < NLAT) { b = row >> 13; kpos = row & (S_ - 1); }
  else { int r = row - NLAT; b = r >> 8; kpos = S_ + (r & (L_ - 1)); }
}

DI void phase0(const Params& p, char* lds) {
  const int tid = tid_();
  for (int u = bid_(); u < 384; u += gridDim.x) {
    const int layer = u / 96, chunk = u % 96;
    float* sl = (float*)lds; float* red = (float*)(lds + 12288);
    for (int idx = tid; idx < 3072; idx += NTHR) {
      int m = idx >> 10, k = idx & 1023;
      float v = m < 2 ? p.c[m * 1024 + k] : p.c_ctx[k];
      sl[idx] = v / (1.0f + expf(-v));
    }
    __syncthreads();
    const int cgp = tid & 15, ks = tid >> 4, col = chunk * 64 + cgp * 4;
    f32x4 a0 = {0, 0, 0, 0}, a1 = a0, a2 = a0;
    const float* wp = p.ada_w + ((size_t)layer * 1024 + ks * 32) * 6144 + col;
#pragma unroll 8
    for (int kk = 0; kk < 32; ++kk) {
      f32x4 w = *(const f32x4*)(wp + (size_t)kk * 6144);
      int k = ks * 32 + kk;
      a0 += w * sl[k]; a1 += w * sl[1024 + k]; a2 += w * sl[2048 + k];
    }
    *(f32x4*)(red + (ks * 3 + 0) * 64 + cgp * 4) = a0;
    *(f32x4*)(red + (ks * 3 + 1) * 64 + cgp * 4) = a1;
    *(f32x4*)(red + (ks * 3 + 2) * 64 + cgp * 4) = a2;
    __syncthreads();
    if (tid < 192) {
      int m = tid >> 6, cc = tid & 63;
      float s = p.ada_b[layer * 6144 + chunk * 64 + cc];
#pragma unroll
      for (int k2 = 0; k2 < 32; ++k2) s += red[(k2 * 3 + m) * 64 + cc];
      p.mod[(layer * 3 + m) * 6144 + chunk * 64 + cc] = s;
    }
    __syncthreads();
  }
  for (int u = bid_(); u < p.ntiles_w; u += gridDim.x) {
    int j = 0;
    while (j + 1 < p.njobs && u >= p.jobs[j + 1].tile0) ++j;
    const WJob jb = p.jobs[j];
    const int t = u - jb.tile0, kt = t / jb.ntn, nt = t % jb.ntn;
    float* tile = (float*)lds;
#pragma unroll
    for (int i = 0; i < 2; ++i) {
      int r = (tid >> 4) + 32 * i, c4 = tid & 15, col = nt * 64 + c4 * 4;
      f32x4 v = {0, 0, 0, 0};
      if (col < jb.N) v = *(const f32x4*)(jb.src + (size_t)(kt * 64 + r) * jb.N + col);
      tile[r * 65 + c4 * 4 + 0] = v[0]; tile[r * 65 + c4 * 4 + 1] = v[1]; tile[r * 65 + c4 * 4 + 2] = v[2]; tile[r * 65 + c4 * 4 + 3] = v[3];
    }
    __syncthreads();
    {
      int idx = tid, n = idx >> 3, kc = idx & 7;
      float v[8];
#pragma unroll
      for (int e = 0; e < 8; ++e) v[e] = tile[(kc * 8 + e) * 65 + n];
      u32x4 w; w.x = pk2(v[0], v[1]); w.y = pk2(v[2], v[3]); w.z = pk2(v[4], v[5]); w.w = pk2(v[6], v[7]);
      *(u32x4*)(jb.dst + (size_t)(nt * 64 + n) * jb.K + kt * 64 + kc * 8) = w;
    }
    __syncthreads();
  }
  const size_t gtid = (size_t)bid_() * NTHR + tid, gsz = (size_t)gridDim.x * NTHR;
  for (size_t i = gtid; i < (size_t)512 * 256; i += gsz) ((f32x4*)p.xc)[i] = ((const f32x4*)p.ctx)[i];
  for (size_t i = gtid; i < (size_t)S_ * 24; i += gsz) {
    int t = (int)(i / 24), j = (int)(i % 24);
    float row = (float)(t >> 6), col = (float)(t & 63);
    float sr, cr, sc, cc;
    if (j < 16) {
      float f = p.freq64[j];
      sincos_d(row * f, sr, cr); sincos_d(col * f, sc, cc);
      float* d = p.rope64 + (size_t)t * 64;
      d[j] = cr; d[16 + j] = sr; d[32 + j] = cc; d[48 + j] = sc;
    } else {
      int jj = j - 16; float f = p.freq32[jj];
      sincos_d(row * f, sr, cr); sincos_d(col * f, sc, cc);
      float* d = p.rope32 + (size_t)t * 32;
      d[jj] = cr; d[8 + jj] = sr; d[16 + jj] = cc; d[24 + jj] = sc;
    }
  }
}

DI void modulate_phase(const Params& p, int layer, int which, int nrows, int nparts, const float* pgate) {
  const int lane = tid_() & 63, wid = tid_() >> 6;
  const float* gn = (which ? p.norm2_g : p.norm1_g) + layer * 1024;
  for (int row = bid_() * NWV + wid; row < nrows; row += gridDim.x * NWV) {
    const int m = row < S_ ? 0 : (row < NLAT ? 1 : 2);
    const float* xr = row < NLAT ? ((layer == 0 && which == 0) ? p.x : p.out) + (size_t)row * 1024 : p.xc + (size_t)(row - NLAT) * 1024;
    const float* md = p.mod + (layer * 3 + m) * 6144 + (which ? 3072 : 0);
    f32x4 v[4]; float ss = 0.f;
#pragma unroll
    for (int i = 0; i < 4; ++i) { v[i] = *(const f32x4*)(xr + i * 256 + lane * 4); ss += v[i][0] * v[i][0] + v[i][1] * v[i][1] + v[i][2] * v[i][2] + v[i][3] * v[i][3]; }
    if (nparts > 0 && row >= NLAT) {
      ss = 0.f;
#pragma unroll
      for (int i = 0; i < 4; ++i) {
        const int c = i * 256 + lane * 4;
        f32x4 acc = {0.f, 0.f, 0.f, 0.f};
        for (int s2 = 0; s2 < nparts; ++s2) acc += *(const f32x4*)(p.part + ((size_t)s2 * 512 + (row - NLAT)) * 1024 + c);
        v[i] += *(const f32x4*)(pgate + c) * acc;
        *(f32x4*)(p.xc + (size_t)(row - NLAT) * 1024 + c) = v[i];
        ss += v[i][0] * v[i][0] + v[i][1] * v[i][1] + v[i][2] * v[i][2] + v[i][3] * v[i][3];
      }
    }
    ss = wave_sum(ss);
    const float rstd = rsqrtf(ss * (1.0f / 1024.0f) + EPS_);
#pragma unroll
    for (int i = 0; i < 4; ++i) {
      const int c = i * 256 + lane * 4;
      f32x4 g = *(const f32x4*)(gn + c), sh = *(const f32x4*)(md + c), sc = *(const f32x4*)(md + 1024 + c);
      f32x4 h = (v[i] * rstd * g) * (sc + 1.0f) + sh;
      u32x2 w; w.x = pk2(h[0], h[1]); w.y = pk2(h[2], h[3]);
      *(u32x2*)(p.H + (size_t)row * 1024 + c) = w;
    }
  }
}

namespace pg8 {
#define PG8_LAS __attribute__((address_space(3)))
typedef unsigned short bf16_t;
typedef short bf16x8 __attribute__((ext_vector_type(8)));
typedef float f32x4 __attribute__((ext_vector_type(4)));
typedef unsigned u32x4 __attribute__((ext_vector_type(4)));
constexpr int BM = 256, BK = 64, HALF = 128, HTB = HALF * BK * 2  , STAGE_BYTES = 8 * HTB, NXCD = 8, WGM = 8;

__host__ __device__ __forceinline__ int lds_byte(int r, int c) { const int st = (r >> 4) * 2 + (c >> 5), rr = r & 15, cc = c & 31, ob = rr * 64 + cc * 2; return st * 1024 + (ob ^ (((ob >> 9) & 1) << 5)); }
__host__ __device__ __forceinline__ void stage_rc(int b, int& R, int& C) { const int st = b / 1024, sb = b % 1024, swz = sb ^ (((sb >> 9) & 1) << 5); R = (st >> 1) * 16 + swz / 64; C = (st & 1) * 32 + (swz % 64) / 2; }
__host__ __device__ __forceinline__ int perm32(int rho) { const int n = rho >> 4, i = rho & 15; return 8 * (i >> 2) + 4 * n + (i & 3); }

struct Unit { int pm, pn; };
struct Gemm { const bf16_t* A; const bf16_t* Bt; int M, N, K, ld; };

struct StaticOrder {
    int nM, nN, nwg, G, c;
    __host__ __device__ void init(int M, int N, int G_, int c_) { nM = M / BM; nN = N / BM; nwg = nM * nN; G = G_; c = c_; }
    __host__ __device__ bool next(int i, Unit& u) const {
        const long L = (long)i * G + c; if (L >= nwg) return false;
        int wgid = (int)L; { const int q = nwg / NXCD, r = nwg % NXCD, xcd = wgid % NXCD, off = wgid / NXCD; wgid = (xcd < r ? xcd * (q + 1) : r * (q + 1) + (xcd - r) * q) + off; }
        const int nig = WGM * nN, gid = wgid / nig, fm = gid * WGM, gsz = (nM - fm) < WGM ? (nM - fm) : WGM;
        u.pm = fm + ((wgid % nig) % gsz); u.pn = (wgid % nig) / gsz; return true;
    }
    __device__ __forceinline__ void a_ready(const Unit&) const {}
    __device__ __forceinline__ void done(const Unit&) const {}
};


typedef float f32x4v __attribute__((ext_vector_type(4)));
template <int ACT> struct EpiStore {
    static constexpr bool PERM = true, AFTER_DRAIN = false;
    bf16_t* O; int ldc;
    __device__ __forceinline__ void operator()(const f32x4 (&acc)[2][2][4][2], const Unit& u, int wr, int wc, int fr, int fq) const {
        const int row0 = u.pm * BM + wr * 64 + fr, col0 = u.pn * BM + wc * 32 + 8 * fq;
#pragma unroll
        for (int ai = 0; ai < 2; ++ai)
#pragma unroll
            for (int m = 0; m < 4; ++m) { bf16_t* rowp = O + (size_t)(row0 + ai * HALF + m * 16) * ldc + col0;
#pragma unroll
                for (int bj = 0; bj < 2; ++bj) { f32x4 v0 = acc[ai][bj][m][0], v1 = acc[ai][bj][m][1];
                    if (ACT == 2) {
#pragma unroll
                        for (int e = 0; e < 4; ++e) { float a = v0[e] > 0.f ? v0[e] : 0.f; v0[e] = a * a; float b = v1[e] > 0.f ? v1[e] : 0.f; v1[e] = b * b; } }
                    u32x4 w; w.x = ::pk2(v0[0], v0[1]); w.y = ::pk2(v0[2], v0[3]); w.z = ::pk2(v1[0], v1[1]); w.w = ::pk2(v1[2], v1[3]);
                    *(u32x4*)(rowp + bj * HALF) = w; } }
    }
};
struct EpiPartial {
    static constexpr bool PERM = false, AFTER_DRAIN = false;
    float* part;
    __device__ __forceinline__ void operator()(const f32x4 (&acc)[2][2][4][2], const Unit& u, int wr, int wc, int fr, int fq) const {
        const int col0 = u.pn * BM + wc * 32 + 4 * fq;
#pragma unroll
        for (int ai = 0; ai < 2; ++ai)
#pragma unroll
            for (int m = 0; m < 4; ++m) { float* pr = part + (size_t)(u.pm * BM + ai * HALF + wr * 64 + m * 16 + fr) * 1024 + col0;
#pragma unroll
                for (int bj = 0; bj < 2; ++bj)
#pragma unroll
                    for (int n = 0; n < 2; ++n) *(f32x4*)(pr + bj * HALF + n * 16) = acc[ai][bj][m][n]; }
    }
};
struct EpiRes {
    static constexpr bool PERM = false, AFTER_DRAIN = false;
    const float* xsrc; float* xlat; float* xctx; const float* gate_base;
    __device__ __forceinline__ void operator()(const f32x4 (&acc)[2][2][4][2], const Unit& u, int wr, int wc, int fr, int fq) const {
        const int mi = u.pm < 32 ? 0 : (u.pm < 64 ? 1 : 2);
        const float* gate = gate_base + mi * 6144;
        const int col0 = u.pn * BM + wc * 32 + 4 * fq;
        f32x4 gv[2][2];
#pragma unroll
        for (int bj = 0; bj < 2; ++bj)
#pragma unroll
            for (int n = 0; n < 2; ++n) gv[bj][n] = *(const f32x4*)(gate + col0 + bj * HALF + n * 16);
#pragma unroll
        for (int ai = 0; ai < 2; ++ai)
#pragma unroll
            for (int m = 0; m < 4; ++m) { const int r = u.pm * BM + ai * HALF + wr * 64 + m * 16 + fr;
                float* xr = r < ::NLAT ? xlat + (size_t)r * 1024 : xctx + (size_t)(r - ::NLAT) * 1024;
                const float* xs = r < ::NLAT ? xsrc + (size_t)r * 1024 : xr;
#pragma unroll
                for (int bj = 0; bj < 2; ++bj)
#pragma unroll
                    for (int n = 0; n < 2; ++n) { const int cc = col0 + bj * HALF + n * 16; f32x4 xv = *(const f32x4*)(xs + cc); xv += gv[bj][n] * acc[ai][bj][m][n]; *(f32x4*)(xr + cc) = xv; } }
    }
};
template <class Epi, class Sched, bool ALIGN_EPI = false, bool SP2 = false>
__device__ __forceinline__ void gemm_phase(PG8_LAS unsigned char* lds, const Gemm g, const Sched& S, const Epi& E) {
    const int tid = ::tid_(), wid = __builtin_amdgcn_readfirstlane(tid >> 6), lane = tid & 63, wr = wid >> 2, wc = wid & 3, fr = lane & 15, fq = lane >> 4;
    const int K = g.ld, nt = g.K / BK;
    unsigned voffA[2], voffB[2];
#pragma unroll
    for (int i = 0; i < 2; ++i) { int R, C; stage_rc(tid * 16 + i * 8192, R, C); const int Rb = Epi::PERM ? ((R & ~31) + perm32(R & 31)) : R;
        voffA[i] = (unsigned)(R * K + C) * 2u; voffB[i] = (unsigned)(Rb * K + C) * 2u; }
    const size_t kstep = (size_t)(BK * 2);
    const size_t hstep = (size_t)HALF * K * 2;
    const size_t tstep = 2 * hstep;
    const unsigned ldsw = (unsigned)wid * 1024u;
    const int aoff = lds_byte(wr * 64 + fr, fq * 8), boff = lds_byte(wc * 32 + fr, fq * 8);
#define PG8_SA(b, h) (((b) * 2 + (h)) * HTB)
#define PG8_SB(b, h) ((4 + (b) * 2 + (h)) * HTB)
#define PG8_STAGE(bufoff, gbase, voff) do { _Pragma("unroll") for (int _i = 0; _i < 2; ++_i) \
        __builtin_amdgcn_global_load_lds((const unsigned*)((const char*)(gbase) + (voff)[_i]), (PG8_LAS unsigned*)(lds + (bufoff) + ldsw + _i * 8192), 16, 0, 0); } while (0)
#define PG8_LDA(dst, b, h) do { _Pragma("unroll") for (int m = 0; m < 4; ++m) _Pragma("unroll") for (int k = 0; k < 2; ++k) dst[m][k] = *(const PG8_LAS bf16x8*)(lds + PG8_SA(b, h) + aoff + m * 2048 + k * 1024); } while (0)
#define PG8_LDB(dst, b, h) do { _Pragma("unroll") for (int n = 0; n < 2; ++n) _Pragma("unroll") for (int k = 0; k < 2; ++k) dst[n][k] = *(const PG8_LAS bf16x8*)(lds + PG8_SB(b, h) + boff + n * 2048 + k * 1024); } while (0)
#define PG8_MMA(ai, bj, At, Bt) do { __builtin_amdgcn_s_setprio(1); _Pragma("unroll") for (int m = 0; m < 4; ++m) _Pragma("unroll") for (int n = 0; n < 2; ++n) _Pragma("unroll") for (int k = 0; k < 2; ++k) \
        acc[ai][bj][m][n] = __builtin_amdgcn_mfma_f32_16x16x32_bf16(Bt[n][k], At[m][k], acc[ai][bj][m][n], 0, 0, 0); __builtin_amdgcn_s_setprio(0); } while (0)
#define PG8_WAIT_V(n) asm volatile("s_waitcnt vmcnt(" #n ")" ::: "memory")
#define PG8_WAIT_L(n) asm volatile("s_waitcnt lgkmcnt(" #n ")" ::: "memory")
#define PG8_BAR __builtin_amdgcn_s_barrier()
#define PG8_SCHED __builtin_amdgcn_sched_barrier(0)
    Unit cur, nxt; int ui = 0;
    if (!S.next(0, cur)) return;
    f32x4 acc[2][2][4][2];
#pragma unroll
    for (int a = 0; a < 2; ++a)
#pragma unroll
        for (int b = 0; b < 2; ++b)
#pragma unroll
            for (int m = 0; m < 4; ++m)
#pragma unroll
                for (int n = 0; n < 2; ++n) acc[a][b][m][n] = (f32x4){0.f, 0.f, 0.f, 0.f};
    bf16x8 At[4][2], B0[2][2], B1[2][2];
    const char* cA = (const char*)g.A + (size_t)cur.pm * tstep; const char* cB = (const char*)g.Bt + (size_t)cur.pn * tstep;
    S.a_ready(cur);
    if constexpr (SP2) {
        PG8_STAGE(PG8_SB(0, 0), cB, voffB); PG8_STAGE(PG8_SB(0, 1), cB + hstep, voffB); PG8_STAGE(PG8_SA(0, 0), cA, voffA); PG8_STAGE(PG8_SA(0, 1), cA + hstep, voffA);
        if (wr == 1) PG8_BAR;
        PG8_WAIT_V(2); PG8_BAR;
        PG8_STAGE(PG8_SB(1, 0), cB + kstep, voffB); PG8_STAGE(PG8_SA(1, 0), cA + kstep, voffA); PG8_STAGE(PG8_SB(1, 1), cB + hstep + kstep, voffB);
        PG8_WAIT_V(6); PG8_BAR;
    } else {
        PG8_STAGE(PG8_SB(0, 0), cB, voffB); PG8_STAGE(PG8_SA(0, 0), cA, voffA); PG8_STAGE(PG8_SB(0, 1), cB + hstep, voffB); PG8_STAGE(PG8_SA(0, 1), cA + hstep, voffA);
        if (wr == 1) PG8_BAR;
        PG8_WAIT_V(4); PG8_BAR;
        PG8_STAGE(PG8_SB(1, 0), cB + kstep, voffB); PG8_STAGE(PG8_SA(1, 0), cA + kstep, voffA); PG8_STAGE(PG8_SB(1, 1), cB + hstep + kstep, voffB);
        PG8_WAIT_V(6); PG8_BAR;
    }
    for (;;) {
        const bool has_next = S.next(ui + 1, nxt);
        const char* nA = has_next ? (const char*)g.A + (size_t)nxt.pm * tstep : cA; const char* nB = has_next ? (const char*)g.Bt + (size_t)nxt.pn * tstep : cB;
        for (int t = 0; t < nt; t += 2) {
            const bool last = (t == nt - 2);
            const char* a1 = cA + (size_t)(t + 1) * kstep;
            const char* a2 = last ? nA : cA + (size_t)(t + 2) * kstep; const char* b2 = last ? nB : cB + (size_t)(t + 2) * kstep;
            const char* a3 = a2 + kstep; const char* b3 = b2 + kstep;
            if (last && has_next) S.a_ready(nxt);
            if constexpr (SP2) {
            PG8_LDB(B0, 0, 0); PG8_LDB(B1, 0, 1); PG8_SCHED; PG8_LDA(At, 0, 0); PG8_STAGE(PG8_SA(1, 1), a1 + hstep, voffA);
            PG8_WAIT_V(8); PG8_WAIT_L(0); PG8_BAR; PG8_MMA(0, 0, At, B0); PG8_MMA(0, 1, At, B1); PG8_BAR; PG8_SCHED;
            PG8_LDA(At, 0, 1); PG8_STAGE(PG8_SB(0, 0), b2, voffB); PG8_STAGE(PG8_SB(0, 1), b2 + hstep, voffB); PG8_STAGE(PG8_SA(0, 0), a2, voffA);
            PG8_WAIT_V(8); PG8_WAIT_L(0); PG8_BAR; PG8_MMA(1, 0, At, B0); PG8_MMA(1, 1, At, B1); PG8_BAR; PG8_SCHED;
            PG8_LDB(B0, 1, 0); PG8_LDB(B1, 1, 1); PG8_SCHED; PG8_LDA(At, 1, 0); PG8_STAGE(PG8_SA(0, 1), a2 + hstep, voffA);
            PG8_WAIT_V(8); PG8_WAIT_L(0); PG8_BAR; PG8_MMA(0, 0, At, B0); PG8_MMA(0, 1, At, B1); PG8_BAR; PG8_SCHED;
            PG8_LDA(At, 1, 1); PG8_STAGE(PG8_SB(1, 0), b3, voffB); PG8_STAGE(PG8_SB(1, 1), b3 + hstep, voffB); PG8_STAGE(PG8_SA(1, 0), a3, voffA);
            PG8_WAIT_V(8); PG8_WAIT_L(0); PG8_BAR; PG8_MMA(1, 0, At, B0); PG8_MMA(1, 1, At, B1); PG8_BAR; PG8_SCHED;
            } else {
            PG8_LDB(B0, 0, 0); PG8_SCHED; PG8_LDA(At, 0, 0); PG8_STAGE(PG8_SA(1, 1), a1 + hstep, voffA);
            PG8_WAIT_L(8); PG8_BAR; PG8_WAIT_L(0); PG8_MMA(0, 0, At, B0); PG8_BAR; PG8_SCHED;
            PG8_LDB(B1, 0, 1); PG8_STAGE(PG8_SB(0, 0), b2, voffB);
            PG8_BAR; PG8_WAIT_L(0); PG8_MMA(0, 1, At, B1); PG8_BAR;
            PG8_LDA(At, 0, 1); PG8_STAGE(PG8_SA(0, 0), a2, voffA);
            PG8_BAR; PG8_WAIT_L(0); PG8_MMA(1, 0, At, B0); PG8_BAR; PG8_SCHED;
            PG8_STAGE(PG8_SB(0, 1), b2 + hstep, voffB);
            PG8_WAIT_V(6); PG8_BAR; PG8_MMA(1, 1, At, B1); PG8_BAR;
            PG8_LDB(B0, 1, 0); PG8_SCHED; PG8_LDA(At, 1, 0); PG8_STAGE(PG8_SA(0, 1), a2 + hstep, voffA);
            PG8_WAIT_L(8); PG8_BAR; PG8_WAIT_L(0); PG8_MMA(0, 0, At, B0); PG8_BAR; PG8_SCHED;
            PG8_LDB(B1, 1, 1); PG8_STAGE(PG8_SB(1, 0), b3, voffB);
            PG8_BAR; PG8_WAIT_L(0); PG8_MMA(0, 1, At, B1); PG8_BAR;
            PG8_LDA(At, 1, 1); PG8_STAGE(PG8_SA(1, 0), a3, voffA);
            PG8_BAR; PG8_WAIT_L(0); PG8_MMA(1, 0, At, B0); PG8_BAR; PG8_SCHED;
            PG8_STAGE(PG8_SB(1, 1), b3 + hstep, voffB);
            PG8_WAIT_V(6); PG8_BAR; PG8_MMA(1, 1, At, B1); PG8_BAR;
            }
        }
        if constexpr (ALIGN_EPI) { if (wr == 0) PG8_BAR; }
        if constexpr (!Epi::AFTER_DRAIN) { E(acc, cur, wr, wc, fr, fq); S.done(cur); }
        if (!has_next) break;
#pragma unroll
        for (int a = 0; a < 2; ++a)
#pragma unroll
            for (int b = 0; b < 2; ++b)
#pragma unroll
                for (int m = 0; m < 4; ++m)
#pragma unroll
                    for (int n = 0; n < 2; ++n) acc[a][b][m][n] = (f32x4){0.f, 0.f, 0.f, 0.f};
        cur = nxt; cA = nA; cB = nB; ++ui;
        if constexpr (ALIGN_EPI) { if (wr == 1) PG8_BAR; }
    }
    PG8_WAIT_V(0);
    if constexpr (!ALIGN_EPI) { if (wr == 0) PG8_BAR; }
    PG8_BAR;
    if constexpr (Epi::AFTER_DRAIN) { E.fused(acc, cur, wr, wc, fr, fq, lds, wid, lane); S.done(cur); }
#undef PG8_SA
#undef PG8_SB
#undef PG8_STAGE
#undef PG8_LDA
#undef PG8_LDB
#undef PG8_MMA
#undef PG8_WAIT_V
#undef PG8_WAIT_L
#undef PG8_BAR
#undef PG8_SCHED
}
}

DI void transpose_chunk(char* lds, const bf16_t* src_row0, int ld, int colA, int colB, bf16_t* dst  ) {
  const int tid = tid_();
#pragma unroll
  for (int i = 0; i < 2; ++i) {
    int idx = tid + NTHR * i, tok = idx >> 4, ch = idx & 15;
    int col = ch < 8 ? colA + ch * 8 : colB + (ch - 8) * 8;
    u32x4 v = *(const u32x4*)(src_row0 + (size_t)tok * ld + col);
    *(u32x4*)(lds + tok * 272 + ch * 16) = v;
  }
  __syncthreads();
#pragma unroll
  for (int i = 0; i < 2; ++i) {
    int idx = tid + NTHR * i, col = idx >> 3, pc = idx & 7;
    unsigned short v[8];
#pragma unroll
    for (int j = 0; j < 8; ++j) { int tl = 16 * (pc >> 1) + 8 * (j >> 2) + 4 * (pc & 1) + (j & 3); v[j] = *(const unsigned short*)(lds + tl * 272 + col * 2); }
    u32x4 w; w.x = v[0] | ((unsigned)v[1] << 16); w.y = v[2] | ((unsigned)v[3] << 16); w.z = v[4] | ((unsigned)v[5] << 16); w.w = v[6] | ((unsigned)v[7] << 16);
    *(u32x4*)(dst + (size_t)col * KV_ + pc * 8) = w;
  }
  __syncthreads();
}

DI void unpack8(u32x4 r, float (&v)[8]) { v[0] = lo2f(r.x); v[1] = hi2f(r.x); v[2] = lo2f(r.y); v[3] = hi2f(r.y); v[4] = lo2f(r.z); v[5] = hi2f(r.z); v[6] = lo2f(r.w); v[7] = hi2f(r.w); }
DI u32x4 pack8(const float (&v)[8]) { u32x4 w; w.x = pk2(v[0], v[1]); w.y = pk2(v[2], v[3]); w.z = pk2(v[4], v[5]); w.w = pk2(v[6], v[7]); return w; }

DI void norm_rope64(float (&v)[8], const float* gain, int lane, bool rope, const float* tab  , float scale) {
  float ss = 0.f;
#pragma unroll
  for (int e = 0; e < 8; ++e) ss += v[e] * v[e];
  ss += __shfl_xor(ss, 1); ss += __shfl_xor(ss, 2); ss += __shfl_xor(ss, 4);
  const float rstd = rsqrtf(ss * (1.0f / 64.0f) + EPS_);
  const int sl = lane & 7;
  f32x4 g0 = *(const f32x4*)(gain + sl * 8), g1 = *(const f32x4*)(gain + sl * 8 + 4);
  v[0] *= rstd * g0[0]; v[1] *= rstd * g0[1]; v[2] *= rstd * g0[2]; v[3] *= rstd * g0[3];
  v[4] *= rstd * g1[0]; v[5] *= rstd * g1[1]; v[6] *= rstd * g1[2]; v[7] *= rstd * g1[3];
  float pr[8];
#pragma unroll
  for (int e = 0; e < 8; ++e) pr[e] = __shfl_xor(v[e], 2);
  if (rope) {
    const int base = (sl >> 2) * 32 + (sl & 1) * 8;
    const float sgn = (sl & 2) ? 1.0f : -1.0f;
    f32x4 c0 = *(const f32x4*)(tab + base), c1 = *(const f32x4*)(tab + base + 4), s0 = *(const f32x4*)(tab + base + 16), s1 = *(const f32x4*)(tab + base + 20);
#pragma unroll
    for (int e = 0; e < 4; ++e) { v[e] = v[e] * c0[e] + sgn * pr[e] * s0[e]; v[4 + e] = v[4 + e] * c1[e] + sgn * pr[4 + e] * s1[e]; }
  }
#pragma unroll
  for (int e = 0; e < 8; ++e) v[e] *= scale;
}

DI void post_even(const Params& p, char* lds, int i2) {
  const int tid = tid_(), lane = tid & 63, wid = tid >> 6;
  const float qscale = 0.125f * LOG2E;
  for (int row = bid_() * NWV + wid; row < NT; row += gridDim.x * NWV) {
    int b, kpos; row_bk(row, b, kpos);
    const bool lat = row < NLAT;
    const bf16_t* src = p.P + (size_t)row * 2304;
    const float* tab = p.rope64 + (size_t)(lat ? kpos : 0) * 64;
    const int l2 = lane & 15;
    const u32x4 r0 = *(const u32x4*)(src + lane * 8), r1 = *(const u32x4*)(src + 512 + lane * 8), r2 = *(const u32x4*)(src + 1536 + lane * 8), r3 = *(const u32x4*)(src + 2048 + l2 * 8);
    float v[8];
    unpack8(r0, v); norm_rope64(v, p.diff_q_g + i2 * 64, lane, lat, tab, qscale);
    *(u32x4*)(p.Q1 + (size_t)row * 512 + lane * 8) = pack8(v);
    unpack8(r1, v); norm_rope64(v, p.diff_k_g + i2 * 64, lane, lat, tab, 1.0f);
    *(u32x4*)(p.K1 + ((size_t)b * KV_ + kpos) * 512 + lane * 8) = pack8(v);
    unpack8(r2, v); norm_rope64(v, p.swa_q_g + i2 * 64, lane, lat, tab, qscale);
    *(u32x4*)(p.Q2 + (size_t)row * 512 + lane * 8) = pack8(v);
    unpack8(r3, v); norm_rope64(v, p.swa_k_g + i2 * 64, lane, lat, tab, 1.0f);
    if (lane < 16) *(u32x4*)(p.K2 + ((size_t)b * KV_ + kpos) * 128 + l2 * 8) = pack8(v);
  }
  for (int item = bid_(); item < (NT / 64) * 5; item += gridDim.x) {
    const int tile = item / 5, cch = item % 5;
    const int r0 = tile * 64; int b, kpos0; row_bk(r0, b, kpos0);
    const bf16_t* srow = p.P + (size_t)r0 * 2304;
    if (cch < 4) transpose_chunk(lds, srow, 2304, 1024 + cch * 128, 1024 + cch * 128 + 64, p.V1t + (size_t)(b * 512 + cch * 128) * KV_ + kpos0);
    else transpose_chunk(lds, srow, 2304, 2176, 2176 + 64, p.V2t + (size_t)(b * 128) * KV_ + kpos0);
  }
}

DI void post_odd_a(const Params& p, char* lds, int i2) {
  const int tid = tid_(), lane = tid & 63, wid = tid >> 6;
  const float qscale = 0.125f * LOG2E;
  for (int row = bid_() * NWV + wid; row < NT; row += gridDim.x * NWV) {
    int b, kpos; row_bk(row, b, kpos);
    const bf16_t* src = p.P + (size_t)row * 2560;
    const int l2 = lane & 31;
    const u32x4 r0 = *(const u32x4*)(src + lane * 8), r1 = *(const u32x4*)(src + 512 + l2 * 8), r2 = *(const u32x4*)(src + 800 + lane * 8), r3 = *(const u32x4*)(src + 1312 + lane * 8);
    u32x4 rk = {0, 0, 0, 0};
    if (lane >= 32 && lane < 36) rk = *(const u32x4*)(src + 768 + (lane - 32) * 8);
    float v[8];
    {
      unpack8(r0, v);
      float ss = 0.f;
#pragma unroll
      for (int e = 0; e < 8; ++e) ss += v[e] * v[e];
      ss = wave_sum(ss);
      const float rstd = rsqrtf(ss * (1.0f / 512.0f) + EPS_);
      const float* g = p.mla_qa_g + i2 * 512 + lane * 8;
#pragma unroll
      for (int e = 0; e < 8; ++e) v[e] *= rstd * g[e];
      *(u32x4*)(p.QAn + (size_t)row * 512 + lane * 8) = pack8(v);
    }
    {
      unpack8(r1, v);
      float ss = 0.f;
#pragma unroll
      for (int e = 0; e < 8; ++e) ss += v[e] * v[e];
#pragma unroll
      for (int o = 16; o >= 1; o >>= 1) ss += __shfl_xor(ss, o);
      const float rstd = rsqrtf(ss * (1.0f / 256.0f) + EPS_);
      const float* g = p.mla_kva_g + i2 * 256 + l2 * 8;
#pragma unroll
      for (int e = 0; e < 8; ++e) v[e] *= rstd * g[e];
      if (lane < 32) *(u32x4*)(p.KVAn + (size_t)row * 256 + l2 * 8) = pack8(v);
      else if (lane < 36) *(u32x4*)(p.KR + (size_t)row * 32 + (lane - 32) * 8) = rk;
    }
    unpack8(r2, v); norm_rope64(v, p.na_q_g + i2 * 64, lane, false, p.rope64, qscale);
    *(u32x4*)(p.Q2 + (size_t)row * 512 + lane * 8) = pack8(v);
    unpack8(r3, v); norm_rope64(v, p.na_k_g + i2 * 64, lane, false, p.rope64, 1.0f);
    *(u32x4*)(p.K2 + ((size_t)b * KV_ + kpos) * 512 + lane * 8) = pack8(v);
  }
  for (int item = bid_(); item < (NT / 64) * 4; item += gridDim.x) {
    const int tile = item >> 2, cch = item & 3;
    const int r0 = tile * 64; int b, kpos0; row_bk(r0, b, kpos0);
    const bf16_t* srow = p.P + (size_t)r0 * 2560;
    transpose_chunk(lds, srow, 2560, 1824 + cch * 128, 1824 + cch * 128 + 64, p.V2t + (size_t)(b * 512 + cch * 128) * KV_ + kpos0);
  }
}

DI void post_odd_c(const Params& p, char* lds, int i2) {
  const int tid = tid_(), lane = tid & 63, wid = tid >> 6;
  const float qscale = 0.10206207261596575f * LOG2E;
  const int sl = lane & 15, hg = lane >> 4;
  for (int row = bid_() * NWV + wid; row < NT; row += gridDim.x * NWV) {
    int b, kpos; row_bk(row, b, kpos);
    const bool lat = row < NLAT;
    u32x4 raw[4];
#pragma unroll
    for (int chunk = 0; chunk < 4; ++chunk) {
      const int head = (chunk & 1) * 4 + hg;
      raw[chunk] = (u32x4){0, 0, 0, 0};
      if (sl < 12) {
        if (chunk < 2) raw[chunk] = *(const u32x4*)(p.QUP + (size_t)row * 768 + head * 96 + sl * 8);
        else if (sl < 8) raw[chunk] = *(const u32x4*)(p.KVUP + (size_t)row * 1024 + head * 128 + sl * 8);
        else raw[chunk] = *(const u32x4*)(p.KR + (size_t)row * 32 + (sl - 8) * 8);
      }
    }
    f32x4 tc0 = {0, 0, 0, 0}, tc1 = tc0, ts0 = tc0, ts1 = tc0;
    const bool dorope = lat && sl >= 8 && sl < 12;
    if (dorope) { const float* tab = p.rope32 + (size_t)kpos * 32 + ((sl - 8) >> 1) * 16; tc0 = *(const f32x4*)tab; tc1 = *(const f32x4*)(tab + 4); ts0 = *(const f32x4*)(tab + 8); ts1 = *(const f32x4*)(tab + 12); }
#pragma unroll
    for (int chunk = 0; chunk < 4; ++chunk) {
      const int head = (chunk & 1) * 4 + hg;
      const bool isq = chunk < 2;
      float v[8];
      unpack8(raw[chunk], v);
      float ss = 0.f;
#pragma unroll
      for (int e = 0; e < 8; ++e) ss += v[e] * v[e];
      ss += __shfl_xor(ss, 1); ss += __shfl_xor(ss, 2); ss += __shfl_xor(ss, 4); ss += __shfl_xor(ss, 8);
      const float rstd = rsqrtf(ss * (1.0f / 96.0f) + EPS_);
      const float* g = (isq ? p.mla_q_g : p.mla_k_g) + i2 * 96 + (sl < 12 ? sl : 0) * 8;
#pragma unroll
      for (int e = 0; e < 8; ++e) v[e] *= rstd * g[e];
      float pr[8];
#pragma unroll
      for (int e = 0; e < 8; ++e) pr[e] = __shfl_xor(v[e], 1);
      if (dorope) {
        const float sgn = (sl & 1) ? 1.0f : -1.0f;
#pragma unroll
        for (int e = 0; e < 4; ++e) { v[e] = v[e] * tc0[e] + sgn * pr[e] * ts0[e]; v[4 + e] = v[4 + e] * tc1[e] + sgn * pr[4 + e] * ts1[e]; }
      }
      if (sl < 12) {
        if (isq) {
#pragma unroll
          for (int e = 0; e < 8; ++e) v[e] *= qscale;
          *(u32x4*)(p.Q1 + (size_t)row * 768 + head * 96 + sl * 8) = pack8(v);
        } else {
          *(u32x4*)(p.K1 + ((size_t)b * KV_ + kpos) * 768 + head * 96 + sl * 8) = pack8(v);
        }
      }
    }
  }
  for (int item = bid_(); item < (NT / 64) * 4; item += gridDim.x) {
    const int tile = item >> 2, cch = item & 3;
    const int r0 = tile * 64; int b, kpos0; row_bk(r0, b, kpos0);
    const bf16_t* srow = p.KVUP + (size_t)r0 * 1024;
    transpose_chunk(lds, srow, 1024, (2 * cch) * 128 + 64, (2 * cch + 1) * 128 + 64, p.V1t + (size_t)(b * 512 + cch * 128) * KV_ + kpos0);
  }
}

constexpr int ATT_STAGE = 31744;
template <int DQK, int DV, int MODE>
DI void attn_core(char* lds, const bf16_t* Qrow, const bf16_t* Kb, int ldk, const bf16_t* Vtb,
                  int t0a, int na, int t0b, int nb, int qpos, const float* rpbL, float bound,
                  f32x16 (&o)[DV / 32], float& l_out) {
  constexpr int KROW = DQK * 2 + 16, KCH = DQK / 8, NKCH = 64 * KCH, NKC = (NKCH + NTHR - 1) / NTHR, NVC = DV * 8 / NTHR, KS = DQK / 16, NDB = DV / 32;
  const int tid = tid_(), lane = tid & 63, l31 = lane & 31, hi = lane >> 5;
  bf16x8 qf[KS];
#pragma unroll
  for (int kk = 0; kk < KS; ++kk) qf[kk] = *(const bf16x8*)(Qrow + kk * 16 + hi * 8);
#pragma unroll
  for (int db = 0; db < NDB; ++db)
#pragma unroll
    for (int i = 0; i < 16; ++i) o[db][i] = 0.f;
  float l = 0.f;
  f32x16 negb;
#pragma unroll
  for (int i = 0; i < 16; ++i) negb[i] = -bound;
  asm volatile("" : "+v"(negb));
  u32x4 rk0[NKC], rv0[NVC], rk1[NKC], rv1[NVC];
  const int n = na + nb;
  int qrow = 0, qcol = 0, rs = 0, cs = 0;
  if (MODE == 2) { qrow = qpos >> 6; qcol = qpos & 63; rs = min(max(qrow - 4, 0), 120); cs = min(max(qcol - 8, 0), 48); }
  int kr_[NKC], kc_[NKC]; bool kok_[NKC];
#pragma unroll
  for (int i = 0; i < NKC; ++i) { int idx = tid + NTHR * i; kok_[i] = idx < NKCH; if (!kok_[i]) idx = 0; kr_[i] = idx / KCH; kc_[i] = idx % KCH; }
  const int vr_ = tid >> 3, vc_ = tid & 7;
#define ATT_TILE(s_) ((s_) < na ? t0a + (s_) : t0b + ((s_) - na))
#define ATT_GLOAD(RK, RV, kt_) do { \
    _Pragma("unroll") for (int i = 0; i < NKC; ++i) if (kok_[i]) RK[i] = *(const u32x4*)(Kb + (size_t)((kt_) * 64 + kr_[i]) * ldk + kc_[i] * 8); \
    _Pragma("unroll") for (int i = 0; i < NVC; ++i) RV[i] = *(const u32x4*)(Vtb + (size_t)(vr_ + 64 * i) * KV_ + (kt_) * 64 + vc_ * 8); } while (0)
#define ATT_LSTORE(RK, RV, base_) do { \
    _Pragma("unroll") for (int i = 0; i < NKC; ++i) if (kok_[i]) *(u32x4*)((base_) + kr_[i] * KROW + kc_[i] * 16) = RK[i]; \
    _Pragma("unroll") for (int i = 0; i < NVC; ++i) *(u32x4*)((base_) + 64 * KROW + (vr_ + 64 * i) * 144 + vc_ * 16) = RV[i]; } while (0)
  ATT_GLOAD(rk0, rv0, ATT_TILE(0));
  if (n > 1) ATT_GLOAD(rk1, rv1, ATT_TILE(1));
  ATT_LSTORE(rk0, rv0, lds);
  __syncthreads();
  auto step = [&](int s, u32x4 (&ldK)[NKC], u32x4 (&ldV)[NVC], u32x4 (&wrK)[NKC], u32x4 (&wrV)[NVC]) {
    const int kt = ATT_TILE(s);
    char* ldsK = lds + (s & 1) * ATT_STAGE; char* ldsV = ldsK + 64 * KROW;
    char* nx = lds + ((s + 1) & 1) * ATT_STAGE;
    if (s + 2 < n) ATT_GLOAD(ldK, ldV, ATT_TILE(s + 2));
    bool rowok = true; int dr = 0;
    if (MODE == 2) { rowok = (kt >= rs) && (kt < rs + 8); dr = kt - qrow + 7; }
#pragma unroll
    for (int sub = 0; sub < 2; ++sub) {
      f32x16 sa;
#pragma unroll
      for (int kk = 0; kk < KS; ++kk) {
        bf16x8 kf = *(const bf16x8*)(ldsK + (sub * 32 + l31) * KROW + kk * 32 + hi * 16);
        if (kk == 0) sa = mfma32(kf, qf[kk], negb); else sa = mfma32(kf, qf[kk], sa);
      }
      if (MODE == 1) {
        if (kt < 128) {
#pragma unroll
          for (int i = 0; i < 16; ++i) {
            const int kpos = kt * 64 + sub * 32 + (i & 3) + 8 * (i >> 2) + 4 * hi;
            const int d = kpos - qpos;
            if (d > 128 || d < -128) sa[i] = -INFINITY;
          }
        }
      } else if (MODE == 2) {
        if (kt < 128) {
#pragma unroll
          for (int i = 0; i < 16; ++i) {
            const int kcol = sub * 32 + (i & 3) + 8 * (i >> 2) + 4 * hi;
            const bool ok = rowok && (kcol >= cs) && (kcol < cs + 16);
            const int idx = ok ? dr * 31 + (kcol - qcol + 15) : 0;
            const float bias = rpbL[idx];
            sa[i] = ok ? sa[i] + bias : -INFINITY;
          }
        }
      }
      f32x2 rs2 = {0.f, 0.f};
#pragma unroll
      for (int i = 0; i < 16; i += 2) { f32x2 pv = {ex2(sa[i]), ex2(sa[i + 1])}; sa[i] = pv[0]; sa[i + 1] = pv[1]; rs2 += pv; }
      l += rs2[0] + rs2[1];
      bf16x8 pf[2];
#pragma unroll
      for (int j = 0; j < 2; ++j) {
        u32x4 w;
        w.x = pk2(sa[8 * j + 0], sa[8 * j + 1]); w.y = pk2(sa[8 * j + 2], sa[8 * j + 3]);
        w.z = pk2(sa[8 * j + 4], sa[8 * j + 5]); w.w = pk2(sa[8 * j + 6], sa[8 * j + 7]);
        pf[j] = __builtin_bit_cast(bf16x8, w);
      }
#pragma unroll
      for (int db = 0; db < NDB; ++db)
#pragma unroll
        for (int j = 0; j < 2; ++j) {
          bf16x8 vf = *(const bf16x8*)(ldsV + (db * 32 + l31) * 144 + (sub * 32 + j * 16 + hi * 8) * 2);
          o[db] = mfma32(vf, pf[j], o[db]);
        }
    }
    if (s + 1 < n) ATT_LSTORE(wrK, wrV, nx);
    __syncthreads();
  };
  for (int s = 0; s < n; s += 2) {
    step(s, rk0, rv0, rk1, rv1);
    if (s + 1 < n) step(s + 1, rk1, rv1, rk0, rv0);
  }
#undef ATT_TILE
#undef ATT_GLOAD
#undef ATT_LSTORE
  l_out = l + __shfl_xor(l, 32);
}

DI float logit_bound(const float* gq, const float* gk, int d, float scale) {
  const int lane = tid_() & 63;
  float a = fabsf(gq[lane]), b = fabsf(gk[lane]);
  if (d > 64 && lane < d - 64) { a = fmaxf(a, fabsf(gq[64 + lane])); b = fmaxf(b, fabsf(gk[64 + lane])); }
#pragma unroll
  for (int o = 32; o >= 1; o >>= 1) { a = fmaxf(a, __shfl_xor(a, o)); b = fmaxf(b, __shfl_xor(b, o)); }
  return (float)d * a * b * scale * LOG2E * 1.02f + 0.25f;
}

template <int NDB>
DI void store_o(bf16_t* dst, const f32x16 (&o)[NDB], float sc, int hi) {
#pragma unroll
  for (int db = 0; db < NDB; ++db)
#pragma unroll
    for (int g = 0; g < 4; ++g) {
      u32x2 w; w.x = pk2(o[db][4 * g] * sc, o[db][4 * g + 1] * sc); w.y = pk2(o[db][4 * g + 2] * sc, o[db][4 * g + 3] * sc);
      *(u32x2*)(dst + db * 32 + 8 * g + 4 * hi) = w;
    }
}

DI void unit_A(const Params& p, char* lds, int layer, int b, int h, int qrow0, int t0a, int na, int t0b, int nb) {
  const int i2 = layer >> 1;
  const int tid = tid_(), lane = tid & 63, wid = tid >> 6, l31 = lane & 31, hi = lane >> 5;
  const int qrow = qrow0 + wid * 32 + l31;
  const bf16_t* Vtb = p.V1t + (size_t)(b * 512 + h * 128) * KV_;
  f32x16 o0[4]; float l0;
  const float bound = logit_bound(p.diff_q_g + i2 * 64, p.diff_k_g + i2 * 64, 64, 0.125f);
  f32x4* sp = (f32x4*)(p.spill + ((size_t)bid_() * NTHR + tid) * 64);
  {
    attn_core<64, 128, 0>(lds, p.Q1 + (size_t)qrow * 512 + (h * 2 + 0) * 64, p.K1 + (size_t)b * KV_ * 512 + (h * 2 + 0) * 64, 512, Vtb, t0a, na, t0b, nb, 0, nullptr, bound, o0, l0);
    const float inv0 = 1.0f / l0;
#pragma unroll
    for (int db = 0; db < 4; ++db)
#pragma unroll
      for (int g = 0; g < 4; ++g) { f32x4 t = {o0[db][4 * g] * inv0, o0[db][4 * g + 1] * inv0, o0[db][4 * g + 2] * inv0, o0[db][4 * g + 3] * inv0}; sp[db * 4 + g] = t; }
  }
  attn_core<64, 128, 0>(lds, p.Q1 + (size_t)qrow * 512 + (h * 2 + 1) * 64, p.K1 + (size_t)b * KV_ * 512 + (h * 2 + 1) * 64, 512, Vtb, t0a, na, t0b, nb, 0, nullptr, bound, o0, l0);
  const float* lv = p.diff_lam + i2 * 256;
  float d01 = wave_sum(lv[lane] * lv[64 + lane]), d23 = wave_sum(lv[128 + lane] * lv[192 + lane]);
  const float lam_init = p.lam_init[layer];
  const float lam = expf(d01) - expf(d23) + lam_init;
  const float c1 = lam / l0;
  float ss = 0.f;
#pragma unroll
  for (int db = 0; db < 4; ++db)
#pragma unroll
    for (int g = 0; g < 4; ++g) { f32x4 t = sp[db * 4 + g];
#pragma unroll
      for (int e = 0; e < 4; ++e) { float d = t[e] - c1 * o0[db][4 * g + e]; o0[db][4 * g + e] = d; ss += d * d; } }
  ss += __shfl_xor(ss, 32);
  const float rstd = rsqrtf(ss * (1.0f / 128.0f) + EPS_) * (1.0f - lam_init);
  const float* sg = p.diff_subln_g + i2 * 128;
  bf16_t* dst = p.H + (size_t)qrow * 1024 + h * 128;
#pragma unroll
  for (int db = 0; db < 4; ++db)
#pragma unroll
    for (int g = 0; g < 4; ++g) {
      f32x4 gg = *(const f32x4*)(sg + db * 32 + 8 * g + 4 * hi);
      u32x2 w; w.x = pk2(o0[db][4 * g] * rstd * gg[0], o0[db][4 * g + 1] * rstd * gg[1]); w.y = pk2(o0[db][4 * g + 2] * rstd * gg[2], o0[db][4 * g + 3] * rstd * gg[3]);
      *(u32x2*)(dst + db * 32 + 8 * g + 4 * hi) = w;
    }
}

template <int DQK, int DV, int MODE>
DI void unit_S(const Params& p, char* lds, const bf16_t* Q, int ldq, int qcoloff, const bf16_t* Kb, int ldk, const bf16_t* Vtb,
               int qrow0, int t0a, int na, int t0b, int nb, int qpos0, const float* rpbL, float bound, bool has_sink, float sink2, int ocol) {
  const int tid = tid_(), lane = tid & 63, wid = tid >> 6, l31 = lane & 31, hi = lane >> 5;
  const int qrow = qrow0 + wid * 32 + l31;
  f32x16 o[DV / 32]; float l;
  attn_core<DQK, DV, MODE>(lds, Q + (size_t)qrow * ldq + qcoloff, Kb, ldk, Vtb, t0a, na, t0b, nb, qpos0 + wid * 32 + l31, rpbL, bound, o, l);
  if (has_sink) l += ex2(sink2 - bound);
  store_o<DV / 32>(p.H + (size_t)qrow * 1024 + ocol, o, 1.0f / l, hi);
}

DI void attn_even(const Params& p, char* lds, int layer, bool need_ctx) {
  const int i2 = layer >> 1;
  if ((tid_() >> 6) >= 4) __builtin_amdgcn_s_setprio(1);
  const int nunits = 256 + 512 + (need_ctx ? 24 : 0);
  for (int u = bid_(); u < nunits; u += gridDim.x) {
    const bool isA = (u < 256) || (u >= 768 && u < 776);
    if (isA) {
      int b, h, qrow0, t0, nt;
      if (u < 256) { const int bh = u & 7, qb = u >> 3; b = bh >> 2; h = bh & 3; qrow0 = b * S_ + qb * 256; t0 = 0; nt = 132; }
      else { const int v = u - 768; b = v >> 2; h = v & 3; qrow0 = NLAT + b * 256; t0 = 128; nt = 4; }
      unit_A(p, lds, layer, b, h, qrow0, t0, nt, 0, 0);
    } else {
      int b, hq, qrow0, ta, na, tb, nb, qpos0;
      if (u < 768) { const int v = u - 256, bh = v & 15, qb = v >> 4; b = bh >> 3; hq = bh & 7; qrow0 = b * S_ + qb * 256; qpos0 = qb * 256;
                     ta = max(0, 4 * qb - 2); na = min(128, 4 * qb + 6) - ta; tb = 128; nb = 4; }
      else { const int v = u - 776; b = v >> 3; hq = v & 7; qrow0 = NLAT + b * 256; qpos0 = 0; ta = 128; na = 4; tb = 0; nb = 0; }
      const int kvh = hq >> 2;
      unit_S<64, 64, 1>(p, lds, p.Q2, 512, hq * 64, p.K2 + (size_t)b * KV_ * 128 + kvh * 64, 128, p.V2t + (size_t)(b * 128 + kvh * 64) * KV_,
                        qrow0, ta, na, tb, nb, qpos0, nullptr, logit_bound(p.swa_q_g + i2 * 64, p.swa_k_g + i2 * 64, 64, 0.125f), true, p.swa_sink[i2 * 8 + hq] * LOG2E, 512 + hq * 64);
    }
  }
}

DI void attn_odd(const Params& p, char* lds, int layer, bool need_ctx) {
  const int i2 = layer >> 1;
  if ((tid_() >> 6) >= 4) __builtin_amdgcn_s_setprio(1);
  const int nunits = 512 + 512 + (need_ctx ? 32 : 0);
  float* rpbL = (float*)(lds + 65536);
  for (int u = bid_(); u < nunits; u += gridDim.x) {
    const bool isC = (u < 512) || (u >= 1024 && u < 1040);
    if (isC) {
      int b, h, qrow0, t0, nt;
      if (u < 512) { const int bh = u & 15, qb = u >> 4; b = bh >> 3; h = bh & 7; qrow0 = b * S_ + qb * 256; t0 = 0; nt = 132; }
      else { const int v = u - 1024; b = v >> 3; h = v & 7; qrow0 = NLAT + b * 256; t0 = 128; nt = 4; }
      unit_S<96, 64, 0>(p, lds, p.Q1, 768, h * 96, p.K1 + (size_t)b * KV_ * 768 + h * 96, 768, p.V1t + (size_t)(b * 512 + h * 64) * KV_,
                        qrow0, t0, nt, 0, 0, 0, nullptr, logit_bound(p.mla_q_g + i2 * 96, p.mla_k_g + i2 * 96, 96, 0.10206207261596575f), false, 0.f, h * 64);
    } else {
      int b, h, qrow0, ta, na, tb, nb, qpos0;
      if (u < 1024) { const int v = u - 512, bh = v & 15, qb = v >> 4; b = bh >> 3; h = bh & 7; qrow0 = b * S_ + qb * 256; qpos0 = qb * 256;
                      const int r0 = 4 * qb, r1 = 4 * qb + 3; ta = min(max(r0 - 4, 0), 120); na = min(max(r1 - 4, 0), 120) + 8 - ta; tb = 128; nb = 4; }
      else { const int v = u - 1040; b = v >> 3; h = v & 7; qrow0 = NLAT + b * 256; qpos0 = 0; ta = 128; na = 4; tb = 0; nb = 0; }
      for (int i = tid_(); i < 465; i += NTHR) rpbL[i] = p.na_rpb[(i2 * 8 + h) * 465 + i] * LOG2E;
      float bmax = 0.f;
      for (int i = tid_() & 63; i < 465; i += 64) bmax = fmaxf(bmax, fabsf(p.na_rpb[(i2 * 8 + h) * 465 + i]));
#pragma unroll
      for (int o2 = 32; o2 >= 1; o2 >>= 1) bmax = fmaxf(bmax, __shfl_xor(bmax, o2));
      __syncthreads();
      unit_S<64, 64, 2>(p, lds, p.Q2, 512, h * 64, p.K2 + (size_t)b * KV_ * 512 + h * 64, 512, p.V2t + (size_t)(b * 512 + h * 64) * KV_,
                        qrow0, ta, na, tb, nb, qpos0, rpbL, logit_bound(p.na_q_g + i2 * 64, p.na_k_g + i2 * 64, 64, 0.125f) + bmax * LOG2E, false, 0.f, 512 + h * 64);
    }
  }
}

template <class Epi>
DI void run_gemm(unsigned char* lds, const bf16_t* A, const bf16_t* Bt, int M, int N, int K, const Epi& E) {
  pg8::Gemm g{A, Bt, M, N, K, K};
  pg8::StaticOrder S; S.init(M, N, (int)gridDim.x, bid_());
  pg8::gemm_phase<Epi, pg8::StaticOrder, true, true>((PG8_LAS unsigned char*)lds, g, S, E);
}

template <int NS>
DI void run_gemm_ctx_splitk(unsigned char* lds, const Params& p, const bf16_t* A  , const bf16_t* Bt, int Kfull) {
  const int G = (int)gridDim.x, c = bid_();
  const int slot = G - 1 - c;
  if (slot >= NS * 8) return;
  const int sl = slot >> 3, un = slot & 7;
  const int Kc = Kfull / NS;
  pg8::Gemm g{A + (size_t)NLAT * Kfull + (size_t)sl * Kc, Bt + (size_t)sl * Kc, 512, 1024, Kc, Kfull};
  pg8::StaticOrder S; S.init(512, 1024, 8, un);
  pg8::EpiPartial E{p.part + (size_t)sl * 512 * 1024};
  pg8::gemm_phase<pg8::EpiPartial, pg8::StaticOrder, true, true>((PG8_LAS unsigned char*)lds, g, S, E);
}

template <int layer>
DI void layer_body(const Params& p, char* lds, unsigned char* lds_u, unsigned& gen) {

    const bool need_ctx = layer < 3;
    const int i2 = layer >> 1;
    const int m_res = need_ctx ? NT : NLAT;
    const float* modl = p.mod + layer * 3 * 6144;
    modulate_phase(p, layer, 0, NT, layer > 0 ? 8 : 0, p.mod + ((layer > 0 ? layer - 1 : 0) * 3 + 2) * 6144 + 5120);
    gbar(p.bar, gen);
    if ((layer & 1) == 0) {
      { pg8::EpiStore<0> E{p.P, 2304}; run_gemm(lds_u, p.H, p.wt_in[layer], NT, 2304, 1024, E); }
      gbar(p.bar, gen);
      post_even(p, lds, i2);
      gbar(p.bar, gen);
      attn_even(p, lds, layer, need_ctx);
      __builtin_amdgcn_s_setprio(0);
    } else {
      { pg8::EpiStore<0> E{p.P, 2560}; run_gemm(lds_u, p.H, p.wt_in[layer], NT, 2560, 1024, E); }
      gbar(p.bar, gen);
      post_odd_a(p, lds, i2);
      gbar(p.bar, gen);
      { pg8::EpiStore<0> E{p.QUP, 768}; run_gemm(lds_u, p.QAn, p.wt_qup[i2], NT, 768, 512, E); }
      { pg8::EpiStore<0> E{p.KVUP, 1024}; run_gemm(lds_u, p.KVAn, p.wt_kvup[i2], NT, 1024, 256, E); }
      gbar(p.bar, gen);
      post_odd_c(p, lds, i2);
      gbar(p.bar, gen);
      attn_odd(p, lds, layer, need_ctx);
      __builtin_amdgcn_s_setprio(0);
    }
    gbar(p.bar, gen);
    { pg8::EpiRes E{layer == 0 ? p.x : p.out, p.out, p.xc, modl + 2048}; run_gemm(lds_u, p.H, p.wt_out[layer], NLAT, 1024, 1024, E); }
    if (need_ctx) run_gemm_ctx_splitk<4>(lds_u, p, p.H, p.wt_out[layer], 1024);
    gbar(p.bar, gen);
    modulate_phase(p, layer, 1, m_res, need_ctx ? 4 : 0, modl + 2 * 6144 + 2048);
    gbar(p.bar, gen);
    { pg8::EpiStore<2> E{p.HID, 4096}; run_gemm(lds_u, p.H, p.wt_1[layer], m_res, 4096, 1024, E); }
    gbar(p.bar, gen);
    { pg8::EpiRes E{p.out, p.out, p.xc, modl + 5120}; run_gemm(lds_u, p.HID, p.wt_2[layer], NLAT, 1024, 4096, E); }
    if (need_ctx) run_gemm_ctx_splitk<8>(lds_u, p, p.HID, p.wt_2[layer], 4096);
    gbar(p.bar, gen);
  }
__global__ void __launch_bounds__(NTHR, 2) mega(Params p) {
  extern __shared__ __attribute__((aligned(16))) unsigned char lds_u[];
  char* lds = (char*)lds_u;
  cg::grid_group grid = cg::this_grid();
  phase0(p, lds);
  grid.sync();
  unsigned gen = 0;
  layer_body<0>(p, lds, lds_u, gen);
  layer_body<1>(p, lds, lds_u, gen);
  layer_body<2>(p, lds, lds_u, gen);
  layer_body<3>(p, lds, lds_u, gen);
}

extern "C" void kernel_launch(void* const* d_in, const int* in_sizes, int n_in, void* d_out, int out_size, void* d_ws, size_t ws_size, hipStream_t stream) {
  static int grid_blocks = 0;
  if (!grid_blocks) {
    int dev = 0, cus = 0, per_cu = 0;
    (void)hipGetDevice(&dev);
    (void)hipDeviceGetAttribute(&cus, hipDeviceAttributeMultiprocessorCount, dev);
    (void)hipFuncSetAttribute((const void*)mega, hipFuncAttributeMaxDynamicSharedMemorySize, LDS_BYTES);
    (void)hipOccupancyMaxActiveBlocksPerMultiprocessor(&per_cu, (const void*)mega, NTHR, LDS_BYTES);
    if (per_cu != 1) per_cu = 1;
    grid_blocks = cus * per_cu;
  }
  Params p{};
  const float** pin = (const float**)&p.x;
  for (int i = 0; i < 29; ++i) pin[i] = (const float*)d_in[i];
  p.out = (float*)d_out;
  char* w = (char*)d_ws;
  size_t off = 0;
  auto take = [&](size_t bytes) { char* r = w + off; off += (bytes + 255) & ~(size_t)255; return r; };
  p.bar = (unsigned*)take(256);
  p.xc = (float*)take((size_t)512 * 1024 * 4);
  p.mod = (float*)take((size_t)4 * 3 * 6144 * 4);
  p.rope64 = (float*)take((size_t)S_ * 64 * 4);
  p.rope32 = (float*)take((size_t)S_ * 32 * 4);
  for (int l = 0; l < 4; ++l) {
    p.wt_in[l] = (bf16_t*)take((size_t)2560 * 1024 * 2);
    p.wt_out[l] = (bf16_t*)take((size_t)1024 * 1024 * 2);
    p.wt_1[l] = (bf16_t*)take((size_t)4096 * 1024 * 2);
    p.wt_2[l] = (bf16_t*)take((size_t)4096 * 1024 * 2);
  }
  for (int i = 0; i < 2; ++i) { p.wt_qup[i] = (bf16_t*)take((size_t)768 * 512 * 2); p.wt_kvup[i] = (bf16_t*)take((size_t)1024 * 256 * 2); }
  p.part = (float*)take((size_t)8 * 512 * 1024 * 4);
  p.H = (bf16_t*)take((size_t)NT * 1024 * 2);
  p.KR = (bf16_t*)take((size_t)NT * 32 * 2);
  char* R = take(0);
  size_t roff = 0;
  auto rtake = [&](size_t bytes) { char* r = R + roff; roff += (bytes + 255) & ~(size_t)255; return r; };
  p.P = (bf16_t*)rtake((size_t)NT * 2560 * 2);
  p.Q1 = (bf16_t*)rtake((size_t)NT * 768 * 2);
  p.K1 = (bf16_t*)rtake((size_t)NT * 768 * 2);
  p.V1t = (bf16_t*)rtake((size_t)1024 * KV_ * 2);
  p.Q2 = (bf16_t*)rtake((size_t)NT * 512 * 2);
  p.K2 = (bf16_t*)rtake((size_t)NT * 512 * 2);
  p.V2t = (bf16_t*)rtake((size_t)1024 * KV_ * 2);
  p.HID = (bf16_t*)R;
  p.spill = (float*)p.P;
  p.QUP = p.P;
  p.KVUP = p.P + (size_t)NT * 768;
  p.QAn = p.H;
  p.KVAn = p.H + (size_t)NT * 512;
  int nj = 0, tiles = 0;
  auto add = [&](const float* src, bf16_t* dst, int K, int N, int Npad) {
    WJob& j = p.jobs[nj++]; j.src = src; j.dst = dst; j.K = K; j.N = N; j.Npad = Npad; j.tile0 = tiles; j.ntn = Npad / 64; j.pad_ = 0; tiles += (K / 64) * (Npad / 64);
  };
  for (int l = 0; l < 4; ++l) {
    const int i = l >> 1;
    if ((l & 1) == 0) add(p.ev_w_in + (size_t)i * 1024 * 2304, p.wt_in[l], 1024, 2304, 2304);
    else add(p.od_w_in + (size_t)i * 1024 * 2336, p.wt_in[l], 1024, 2336, 2560);
    add(p.w_out + (size_t)l * 1024 * 1024, p.wt_out[l], 1024, 1024, 1024);
    add(p.mlp_w1 + (size_t)l * 1024 * 4096, p.wt_1[l], 1024, 4096, 4096);
    add(p.mlp_w2 + (size_t)l * 4096 * 1024, p.wt_2[l], 4096, 1024, 1024);
    if (l & 1) {
      add(p.mla_wq_up + (size_t)i * 512 * 768, p.wt_qup[i], 512, 768, 768);
      add(p.mla_wkv_up + (size_t)i * 256 * 1024, p.wt_kvup[i], 256, 1024, 1024);
    }
  }
  p.njobs = nj; p.ntiles_w = tiles;
  for (int j = 0; j < 16; ++j) p.freq64[j] = powf(10000.0f, -(float)j / 16.0f);
  for (int j = 0; j < 8; ++j) p.freq32[j] = powf(10000.0f, -(float)j / 8.0f);
  for (int l = 0; l < 4; ++l) p.lam_init[l] = (float)(0.8 - 0.6 * exp(-0.3 * (double)l));
  (void)hipMemsetAsync(p.bar, 0, 256, stream);
  void* args[] = {&p};
  hipError_t e = hipLaunchCooperativeKernel((void*)mega, dim3(grid_blocks), dim3(NTHR), args, LDS_BYTES, stream);
  if (e != hipSuccess) fprintf(stderr, "cooperative launch failed: %s (grid %d)\n", hipGetErrorString(e), grid_blocks);
}
```

```cpp
#include <hip/hip_runtime.h>
#include <hip/hip_cooperative_groups.h>
#include <cstdio>
#include <cmath>
namespace cg = cooperative_groups;

typedef unsigned short bf16_t;
typedef short bf16x8 __attribute__((ext_vector_type(8)));
typedef float f32x16 __attribute__((ext_vector_type(16)));
typedef float f32x4 __attribute__((ext_vector_type(4)));
typedef float f32x2 __attribute__((ext_vector_type(2)));
typedef unsigned u32x4 __attribute__((ext_vector_type(4)));
typedef unsigned u32x2 __attribute__((ext_vector_type(2)));
typedef __bf16 bf16v2 __attribute__((ext_vector_type(2)));
#define DI __device__ __forceinline__

constexpr int S_ = 8192, D_ = 1024, L_ = 256, NLAT = 2 * S_, NT = NLAT + 2 * L_, KV_ = S_ + L_;
constexpr int LDS_BYTES = 131072;
constexpr int NTHR = 512, NWV = 8;
constexpr float EPS_ = 1e-6f;
constexpr float LOG2E = 1.4426950408889634f;

DI unsigned pk2(float a, float b) { f32x2 v = {a, b}; bf16v2 r = __builtin_convertvector(v, bf16v2); return __builtin_bit_cast(unsigned, r); }
DI float lo2f(unsigned u) { return __uint_as_float(u << 16); }
DI float hi2f(unsigned u) { return __uint_as_float(u & 0xffff0000u); }
DI f32x16 mfma32(bf16x8 a, bf16x8 b, f32x16 c) { return __builtin_amdgcn_mfma_f32_32x32x16_bf16(a, b, c, 0, 0, 0); }
DI float ex2(float x) { return __builtin_amdgcn_exp2f(x); }

struct WJob { const float* src; bf16_t* dst; int K, N, Npad, tile0; int ntn, pad_; };

struct Params {
  const float *x, *c, *ctx, *c_ctx, *ada_w, *ada_b, *norm1_g, *norm2_g, *w_out, *mlp_w1, *mlp_w2,
      *ev_w_in, *diff_q_g, *diff_k_g, *diff_lam, *diff_subln_g, *swa_q_g, *swa_k_g, *swa_sink,
      *od_w_in, *mla_qa_g, *mla_kva_g, *mla_wq_up, *mla_wkv_up, *mla_q_g, *mla_k_g, *na_q_g, *na_k_g, *na_rpb;
  float* out;
  float* xc;
  float* mod;
  float* rope64;
  float* rope32;
  unsigned* bar;
  float* part;
  float* spill;
  bf16_t *wt_in[4], *wt_out[4], *wt_1[4], *wt_2[4], *wt_qup[2], *wt_kvup[2];
  bf16_t *H, *P, *HID, *Q1, *K1, *V1t, *Q2, *K2, *V2t, *QAn, *KVAn, *QUP, *KVUP, *KR;
  WJob jobs[22];
  int njobs, ntiles_w;
  float freq64[16], freq32[8], lam_init[4];
};

DI int tid_() { int t = threadIdx.x; asm volatile("" : "+v"(t)); return t; }
DI int bid_() { int b = blockIdx.x; asm volatile("" : "+s"(b)); return b; }
DI float wave_sum(float v) {
#pragma unroll
  for (int o = 32; o >= 1; o >>= 1) v += __shfl_xor(v, o);
  return v;
}
DI void sincos_d(float x, float& s, float& c) {
  double xd = (double)x;
  double n = rint(xd * 0.15915494309189535);
  double r = xd - n * 6.283185307179586477;
  double r2 = r * r;
  double sp = 1.0 / 51090942171709440000.0;
  sp = sp * (-r2) + 1.0 / 121645100408832000.0;
  sp = sp * (-r2) + 1.0 / 355687428096000.0;
  sp = sp * (-r2) + 1.0 / 1307674368000.0;
  sp = sp * (-r2) + 1.0 / 6227020800.0;
  sp = sp * (-r2) + 1.0 / 39916800.0;
  sp = sp * (-r2) + 1.0 / 362880.0;
  sp = sp * (-r2) + 1.0 / 5040.0;
  sp = sp * (-r2) + 1.0 / 120.0;
  sp = sp * (-r2) + 1.0 / 6.0;
  sp = sp * (-r2) + 1.0;
  double cp = 1.0 / 2432902008176640000.0;
  cp = cp * (-r2) + 1.0 / 6402373705728000.0;
  cp = cp * (-r2) + 1.0 / 20922789888000.0;
  cp = cp * (-r2) + 1.0 / 87178291200.0;
  cp = cp * (-r2) + 1.0 / 479001600.0;
  cp = cp * (-r2) + 1.0 / 3628800.0;
  cp = cp * (-r2) + 1.0 / 40320.0;
  cp = cp * (-r2) + 1.0 / 720.0;
  cp = cp * (-r2) + 1.0 / 24.0;
  cp = cp * (-r2) + 1.0 / 2.0;
  cp = cp * (-r2) + 1.0;
  s = (float)(r * sp);
  c = (float)cp;
}

DI void gbar(unsigned* bar, unsigned& gen) {
  asm volatile("s_waitcnt vmcnt(0)" ::: "memory");
  __syncthreads();
  ++gen;
  if (threadIdx.x == 0) {
    __builtin_amdgcn_fence(__ATOMIC_RELEASE, "agent");
    asm volatile("s_waitcnt vmcnt(0)" ::: "memory");
    __hip_atomic_fetch_add(bar, 1u, __ATOMIC_RELAXED, __HIP_MEMORY_SCOPE_AGENT);
    const unsigned target = gen * gridDim.x;
    while (__hip_atomic_load(bar, __ATOMIC_RELAXED, __HIP_MEMORY_SCOPE_AGENT) < target) __builtin_amdgcn_s_sleep(1);
    __builtin_amdgcn_fence(__ATOMIC_ACQUIRE, "agent");
    asm volatile("s_waitcnt vmcnt(0)" ::: "memory");
  }
  __syncthreads();
}

DI void row_bk(int row, int& b, int& kpos) {
  if (row < NLAT) { b = row >> 13; kpos = row & (S_ - 1); }
  else { int r = row - NLAT; b = r >> 8; kpos = S_ + (r & (L_ - 1)); }
}

DI void phase0(const Params& p, char* lds) {
  const int tid = tid_();
  for (int u = bid_(); u < 384; u += gridDim.x) {
    const int layer = u / 96, chunk = u % 96;
    float* sl = (float*)lds; float* red = (float*)(lds + 12288);
    for (int idx = tid; idx < 3072; idx += NTHR) {
      int m = idx >> 10, k = idx & 1023;
      float v = m < 2 ? p.c[m * 1024 + k] : p.c_ctx[k];
      sl[idx] = v / (1.0f + expf(-v));
    }
    __syncthreads();
    const int cgp = tid & 15, ks = tid >> 4, col = chunk * 64 + cgp * 4;
    f32x4 a0 = {0, 0, 0, 0}, a1 = a0, a2 = a0;
    const float* wp = p.ada_w + ((size_t)layer * 1024 + ks * 32) * 6144 + col;
#pragma unroll 8
    for (int kk = 0; kk < 32; ++kk) {
      f32x4 w = *(const f32x4*)(wp + (size_t)kk * 6144);
      int k = ks * 32 + kk;
      a0 += w * sl[k]; a1 += w * sl[1024 + k]; a2 += w * sl[2048 + k];
    }
    *(f32x4*)(red + (ks * 3 + 0) * 64 + cgp * 4) = a0;
    *(f32x4*)(red + (ks * 3 + 1) * 64 + cgp * 4) = a1;
    *(f32x4*)(red + (ks * 3 + 2) * 64 + cgp * 4) = a2;
    __syncthreads();
    if (tid < 192) {
      int m = tid >> 6, cc = tid & 63;
      float s = p.ada_b[layer * 6144 + chunk * 64 + cc];
#pragma unroll
      for (int k2 = 0; k2 < 32; ++k2) s += red[(k2 * 3 + m) * 64 + cc];
      p.mod[(layer * 3 + m) * 6144 + chunk * 64 + cc] = s;
    }
    __syncthreads();
  }
  {
    float* tile = (float*)lds;
    f32x4 cur[4], nxt[4];
    const int r_ = tid >> 5, c4_ = tid & 31;
    auto locate = [&](int u, WJob& jb, int& kt, int& nt) {
      int j = 0;
      while (j + 1 < p.njobs && u >= p.jobs[j + 1].tile0) ++j;
      jb = p.jobs[j];
      const int t = u - jb.tile0; kt = t / jb.ntn; nt = t % jb.ntn;
    };
    auto gload = [&](f32x4 (&dst)[4], const WJob& jb, int kt, int nt) {
#pragma unroll
      for (int i = 0; i < 4; ++i) {
        const int col = nt * 128 + c4_ * 4;
        dst[i] = (f32x4){0, 0, 0, 0};
        if (col < jb.N) dst[i] = *(const f32x4*)(jb.src + (size_t)(kt * 64 + r_ + 16 * i) * jb.N + col);
      }
    };
    int u = bid_();
    WJob jb; int kt = 0, nt = 0;
    if (u < p.ntiles_w) { locate(u, jb, kt, nt); gload(cur, jb, kt, nt); }
    while (u < p.ntiles_w) {
      const int un = u + (int)gridDim.x;
      WJob jbn = jb; int ktn = 0, ntn = 0;
      if (un < p.ntiles_w) { locate(un, jbn, ktn, ntn); gload(nxt, jbn, ktn, ntn); }
#pragma unroll
      for (int i = 0; i < 4; ++i) {
        float* d = tile + (r_ + 16 * i) * 129 + c4_ * 4;
        d[0] = cur[i][0]; d[1] = cur[i][1]; d[2] = cur[i][2]; d[3] = cur[i][3];
      }
      __syncthreads();
#pragma unroll
      for (int i = 0; i < 2; ++i) {
        const int idx = tid + NTHR * i, n = idx >> 3, kc = idx & 7;
        float v[8];
#pragma unroll
        for (int e = 0; e < 8; ++e) v[e] = tile[(kc * 8 + e) * 129 + n];
        u32x4 w; w.x = pk2(v[0], v[1]); w.y = pk2(v[2], v[3]); w.z = pk2(v[4], v[5]); w.w = pk2(v[6], v[7]);
        *(u32x4*)(jb.dst + (size_t)(nt * 128 + n) * jb.K + kt * 64 + kc * 8) = w;
      }
      __syncthreads();
#pragma unroll
      for (int i = 0; i < 4; ++i) cur[i] = nxt[i];
      jb = jbn; kt = ktn; nt = ntn; u = un;
    }
  }
  const size_t gtid = (size_t)bid_() * NTHR + tid, gsz = (size_t)gridDim.x * NTHR;
  for (size_t i = gtid; i < (size_t)512 * 256; i += gsz) ((f32x4*)p.xc)[i] = ((const f32x4*)p.ctx)[i];
  for (size_t i = gtid; i < (size_t)S_ * 24; i += gsz) {
    int t = (int)(i / 24), j = (int)(i % 24);
    float row = (float)(t >> 6), col = (float)(t & 63);
    float sr, cr, sc, cc;
    if (j < 16) {
      float f = p.freq64[j];
      sincos_d(row * f, sr, cr); sincos_d(col * f, sc, cc);
      float* d = p.rope64 + (size_t)t * 64;
      d[j] = cr; d[16 + j] = sr; d[32 + j] = cc; d[48 + j] = sc;
    } else {
      int jj = j - 16; float f = p.freq32[jj];
      sincos_d(row * f, sr, cr); sincos_d(col * f, sc, cc);
      float* d = p.rope32 + (size_t)t * 32;
      d[jj] = cr; d[8 + jj] = sr; d[16 + jj] = cc; d[24 + jj] = sc;
    }
  }
}

DI void modulate_phase(const Params& p, int layer, int which, int nrows, int nparts, const float* pgate) {
  const int lane = tid_() & 63, wid = tid_() >> 6;
  const float* gn = (which ? p.norm2_g : p.norm1_g) + layer * 1024;
  for (int row = bid_() * NWV + wid; row < nrows; row += gridDim.x * NWV) {
    const int m = row < S_ ? 0 : (row < NLAT ? 1 : 2);
    const float* xr = row < NLAT ? ((layer == 0 && which == 0) ? p.x : p.out) + (size_t)row * 1024 : p.xc + (size_t)(row - NLAT) * 1024;
    const float* md = p.mod + (layer * 3 + m) * 6144 + (which ? 3072 : 0);
    f32x4 v[4]; float ss = 0.f;
#pragma unroll
    for (int i = 0; i < 4; ++i) { v[i] = *(const f32x4*)(xr + i * 256 + lane * 4); ss += v[i][0] * v[i][0] + v[i][1] * v[i][1] + v[i][2] * v[i][2] + v[i][3] * v[i][3]; }
    if (nparts > 0 && row >= NLAT) {
      ss = 0.f;
#pragma unroll
      for (int i = 0; i < 4; ++i) {
        const int c = i * 256 + lane * 4;
        f32x4 acc = {0.f, 0.f, 0.f, 0.f};
        for (int s2 = 0; s2 < nparts; ++s2) acc += *(const f32x4*)(p.part + ((size_t)s2 * 512 + (row - NLAT)) * 1024 + c);
        v[i] += *(const f32x4*)(pgate + c) * acc;
        *(f32x4*)(p.xc + (size_t)(row - NLAT) * 1024 + c) = v[i];
        ss += v[i][0] * v[i][0] + v[i][1] * v[i][1] + v[i][2] * v[i][2] + v[i][3] * v[i][3];
      }
    }
    ss = wave_sum(ss);
    const float rstd = rsqrtf(ss * (1.0f / 1024.0f) + EPS_);
#pragma unroll
    for (int i = 0; i < 4; ++i) {
      const int c = i * 256 + lane * 4;
      f32x4 g = *(const f32x4*)(gn + c), sh = *(const f32x4*)(md + c), sc = *(const f32x4*)(md + 1024 + c);
      f32x4 h = (v[i] * rstd * g) * (sc + 1.0f) + sh;
      u32x2 w; w.x = pk2(h[0], h[1]); w.y = pk2(h[2], h[3]);
      *(u32x2*)(p.H + (size_t)row * 1024 + c) = w;
    }
  }
}

namespace pg8 {
#define PG8_LAS __attribute__((address_space(3)))
typedef unsigned short bf16_t;
typedef short bf16x8 __attribute__((ext_vector_type(8)));
typedef float f32x4 __attribute__((ext_vector_type(4)));
typedef unsigned u32x4 __attribute__((ext_vector_type(4)));
constexpr int BM = 256, BK = 64, HALF = 128, HTB = HALF * BK * 2  , STAGE_BYTES = 8 * HTB, NXCD = 8, WGM = 8;

__host__ __device__ __forceinline__ int lds_byte(int r, int c) { const int st = (r >> 4) * 2 + (c >> 5), rr = r & 15, cc = c & 31, ob = rr * 64 + cc * 2; return st * 1024 + (ob ^ (((ob >> 9) & 1) << 5)); }
__host__ __device__ __forceinline__ void stage_rc(int b, int& R, int& C) { const int st = b / 1024, sb = b % 1024, swz = sb ^ (((sb >> 9) & 1) << 5); R = (st >> 1) * 16 + swz / 64; C = (st & 1) * 32 + (swz % 64) / 2; }
__host__ __device__ __forceinline__ int perm32(int rho) { const int n = rho >> 4, i = rho & 15; return 8 * (i >> 2) + 4 * n + (i & 3); }

struct Unit { int pm, pn; };
struct Gemm { const bf16_t* A; const bf16_t* Bt; int M, N, K, ld; };

struct StaticOrder {
    int nM, nN, nwg, G, c;
    __host__ __device__ void init(int M, int N, int G_, int c_) { nM = M / BM; nN = N / BM; nwg = nM * nN; G = G_; c = c_; }
    __host__ __device__ bool next(int i, Unit& u) const {
        const long L = (long)i * G + c; if (L >= nwg) return false;
        int wgid = (int)L; { const int q = nwg / NXCD, r = nwg % NXCD, xcd = wgid % NXCD, off = wgid / NXCD; wgid = (xcd < r ? xcd * (q + 1) : r * (q + 1) + (xcd - r) * q) + off; }
        const int nig = WGM * nN, gid = wgid / nig, fm = gid * WGM, gsz = (nM - fm) < WGM ? (nM - fm) : WGM;
        u.pm = fm + ((wgid % nig) % gsz); u.pn = (wgid % nig) / gsz; return true;
    }
    __device__ __forceinline__ void a_ready(const Unit&) const {}
    __device__ __forceinline__ void done(const Unit&) const {}
};


typedef float f32x4v __attribute__((ext_vector_type(4)));
template <int ACT> struct EpiStore {
    static constexpr bool PERM = true, AFTER_DRAIN = false;
    bf16_t* O; int ldc;
    __device__ __forceinline__ void operator()(const f32x4 (&acc)[2][2][4][2], const Unit& u, int wr, int wc, int fr, int fq) const {
        const int row0 = u.pm * BM + wr * 64 + fr, col0 = u.pn * BM + wc * 32 + 8 * fq;
#pragma unroll
        for (int ai = 0; ai < 2; ++ai)
#pragma unroll
            for (int m = 0; m < 4; ++m) { bf16_t* rowp = O + (size_t)(row0 + ai * HALF + m * 16) * ldc + col0;
#pragma unroll
                for (int bj = 0; bj < 2; ++bj) { f32x4 v0 = acc[ai][bj][m][0], v1 = acc[ai][bj][m][1];
                    if (ACT == 2) {
#pragma unroll
                        for (int e = 0; e < 4; ++e) { float a = v0[e] > 0.f ? v0[e] : 0.f; v0[e] = a * a; float b = v1[e] > 0.f ? v1[e] : 0.f; v1[e] = b * b; } }
                    u32x4 w; w.x = ::pk2(v0[0], v0[1]); w.y = ::pk2(v0[2], v0[3]); w.z = ::pk2(v1[0], v1[1]); w.w = ::pk2(v1[2], v1[3]);
                    *(u32x4*)(rowp + bj * HALF) = w; } }
    }
};
struct EpiPartial {
    static constexpr bool PERM = false, AFTER_DRAIN = false;
    float* part;
    __device__ __forceinline__ void operator()(const f32x4 (&acc)[2][2][4][2], const Unit& u, int wr, int wc, int fr, int fq) const {
        const int col0 = u.pn * BM + wc * 32 + 4 * fq;
#pragma unroll
        for (int ai = 0; ai < 2; ++ai)
#pragma unroll
            for (int m = 0; m < 4; ++m) { float* pr = part + (size_t)(u.pm * BM + ai * HALF + wr * 64 + m * 16 + fr) * 1024 + col0;
#pragma unroll
                for (int bj = 0; bj < 2; ++bj)
#pragma unroll
                    for (int n = 0; n < 2; ++n) *(f32x4*)(pr + bj * HALF + n * 16) = acc[ai][bj][m][n]; }
    }
};
struct EpiRes {
    static constexpr bool PERM = false, AFTER_DRAIN = false;
    const float* xsrc; float* xlat; float* xctx; const float* gate_base;
    __device__ __forceinline__ void operator()(const f32x4 (&acc)[2][2][4][2], const Unit& u, int wr, int wc, int fr, int fq) const {
        const int mi = u.pm < 32 ? 0 : (u.pm < 64 ? 1 : 2);
        const float* gate = gate_base + mi * 6144;
        const int col0 = u.pn * BM + wc * 32 + 4 * fq;
        f32x4 gv[2][2];
#pragma unroll
        for (int bj = 0; bj < 2; ++bj)
#pragma unroll
            for (int n = 0; n < 2; ++n) gv[bj][n] = *(const f32x4*)(gate + col0 + bj * HALF + n * 16);
#pragma unroll
        for (int ai = 0; ai < 2; ++ai)
#pragma unroll
            for (int m = 0; m < 4; ++m) { const int r = u.pm * BM + ai * HALF + wr * 64 + m * 16 + fr;
                float* xr = r < ::NLAT ? xlat + (size_t)r * 1024 : xctx + (size_t)(r - ::NLAT) * 1024;
                const float* xs = r < ::NLAT ? xsrc + (size_t)r * 1024 : xr;
#pragma unroll
                for (int bj = 0; bj < 2; ++bj)
#pragma unroll
                    for (int n = 0; n < 2; ++n) { const int cc = col0 + bj * HALF + n * 16; f32x4 xv = *(const f32x4*)(xs + cc); xv += gv[bj][n] * acc[ai][bj][m][n]; *(f32x4*)(xr + cc) = xv; } }
    }
};
template <class Epi, class Sched, bool ALIGN_EPI = false, bool SP2 = false>
__device__ __forceinline__ void gemm_phase(PG8_LAS unsigned char* lds, const Gemm g, const Sched& S, const Epi& E) {
    const int tid = ::tid_(), wid = __builtin_amdgcn_readfirstlane(tid >> 6), lane = tid & 63, wr = wid >> 2, wc = wid & 3, fr = lane & 15, fq = lane >> 4;
    const int K = g.ld, nt = g.K / BK;
    unsigned voffA[2], voffB[2];
#pragma unroll
    for (int i = 0; i < 2; ++i) { int R, C; stage_rc(tid * 16 + i * 8192, R, C); const int Rb = Epi::PERM ? ((R & ~31) + perm32(R & 31)) : R;
        voffA[i] = (unsigned)(R * K + C) * 2u; voffB[i] = (unsigned)(Rb * K + C) * 2u; }
    const size_t kstep = (size_t)(BK * 2);
    const size_t hstep = (size_t)HALF * K * 2;
    const size_t tstep = 2 * hstep;
    const unsigned ldsw = (unsigned)wid * 1024u;
    const int aoff = lds_byte(wr * 64 + fr, fq * 8), boff = lds_byte(wc * 32 + fr, fq * 8);
#define PG8_SA(b, h) (((b) * 2 + (h)) * HTB)
#define PG8_SB(b, h) ((4 + (b) * 2 + (h)) * HTB)
#define PG8_STAGE(bufoff, gbase, voff) do { _Pragma("unroll") for (int _i = 0; _i < 2; ++_i) \
        __builtin_amdgcn_global_load_lds((const unsigned*)((const char*)(gbase) + (voff)[_i]), (PG8_LAS unsigned*)(lds + (bufoff) + ldsw + _i * 8192), 16, 0, 0); } while (0)
#define PG8_LDA(dst, b, h) do { _Pragma("unroll") for (int m = 0; m < 4; ++m) _Pragma("unroll") for (int k = 0; k < 2; ++k) dst[m][k] = *(const PG8_LAS bf16x8*)(lds + PG8_SA(b, h) + aoff + m * 2048 + k * 1024); } while (0)
#define PG8_LDB(dst, b, h) do { _Pragma("unroll") for (int n = 0; n < 2; ++n) _Pragma("unroll") for (int k = 0; k < 2; ++k) dst[n][k] = *(const PG8_LAS bf16x8*)(lds + PG8_SB(b, h) + boff + n * 2048 + k * 1024); } while (0)
#define PG8_MMA(ai, bj, At, Bt) do { __builtin_amdgcn_s_setprio(1); _Pragma("unroll") for (int m = 0; m < 4; ++m) _Pragma("unroll") for (int n = 0; n < 2; ++n) _Pragma("unroll") for (int k = 0; k < 2; ++k) \
        acc[ai][bj][m][n] = __builtin_amdgcn_mfma_f32_16x16x32_bf16(Bt[n][k], At[m][k], acc[ai][bj][m][n], 0, 0, 0); __builtin_amdgcn_s_setprio(0); } while (0)
#define PG8_WAIT_V(n) asm volatile("s_waitcnt vmcnt(" #n ")" ::: "memory")
#define PG8_WAIT_L(n) asm volatile("s_waitcnt lgkmcnt(" #n ")" ::: "memory")
#define PG8_BAR __builtin_amdgcn_s_barrier()
#define PG8_SCHED __builtin_amdgcn_sched_barrier(0)
    Unit cur, nxt; int ui = 0;
    if (!S.next(0, cur)) return;
    f32x4 acc[2][2][4][2];
#pragma unroll
    for (int a = 0; a < 2; ++a)
#pragma unroll
        for (int b = 0; b < 2; ++b)
#pragma unroll
            for (int m = 0; m < 4; ++m)
#pragma unroll
                for (int n = 0; n < 2; ++n) acc[a][b][m][n] = (f32x4){0.f, 0.f, 0.f, 0.f};
    bf16x8 At[4][2], B0[2][2], B1[2][2];
    const char* cA = (const char*)g.A + (size_t)cur.pm * tstep; const char* cB = (const char*)g.Bt + (size_t)cur.pn * tstep;
    S.a_ready(cur);
    if constexpr (SP2) {
        PG8_STAGE(PG8_SB(0, 0), cB, voffB); PG8_STAGE(PG8_SB(0, 1), cB + hstep, voffB); PG8_STAGE(PG8_SA(0, 0), cA, voffA); PG8_STAGE(PG8_SA(0, 1), cA + hstep, voffA);
        if (wr == 1) PG8_BAR;
        PG8_WAIT_V(2); PG8_BAR;
        PG8_STAGE(PG8_SB(1, 0), cB + kstep, voffB); PG8_STAGE(PG8_SA(1, 0), cA + kstep, voffA); PG8_STAGE(PG8_SB(1, 1), cB + hstep + kstep, voffB);
        PG8_WAIT_V(6); PG8_BAR;
    } else {
        PG8_STAGE(PG8_SB(0, 0), cB, voffB); PG8_STAGE(PG8_SA(0, 0), cA, voffA); PG8_STAGE(PG8_SB(0, 1), cB + hstep, voffB); PG8_STAGE(PG8_SA(0, 1), cA + hstep, voffA);
        if (wr == 1) PG8_BAR;
        PG8_WAIT_V(4); PG8_BAR;
        PG8_STAGE(PG8_SB(1, 0), cB + kstep, voffB); PG8_STAGE(PG8_SA(1, 0), cA + kstep, voffA); PG8_STAGE(PG8_SB(1, 1), cB + hstep + kstep, voffB);
        PG8_WAIT_V(6); PG8_BAR;
    }
    for (;;) {
        const bool has_next = S.next(ui + 1, nxt);
        const char* nA = has_next ? (const char*)g.A + (size_t)nxt.pm * tstep : cA; const char* nB = has_next ? (const char*)g.Bt + (size_t)nxt.pn * tstep : cB;
        for (int t = 0; t < nt; t += 2) {
            const bool last = (t == nt - 2);
            const char* a1 = cA + (size_t)(t + 1) * kstep;
            const char* a2 = last ? nA : cA + (size_t)(t + 2) * kstep; const char* b2 = last ? nB : cB + (size_t)(t + 2) * kstep;
            const char* a3 = a2 + kstep; const char* b3 = b2 + kstep;
            if (last && has_next) S.a_ready(nxt);
            if constexpr (SP2) {
            PG8_LDB(B0, 0, 0); PG8_LDB(B1, 0, 1); PG8_SCHED; PG8_LDA(At, 0, 0); PG8_STAGE(PG8_SA(1, 1), a1 + hstep, voffA);
            PG8_WAIT_V(8); PG8_WAIT_L(0); PG8_BAR; PG8_MMA(0, 0, At, B0); PG8_MMA(0, 1, At, B1); PG8_BAR; PG8_SCHED;
            PG8_LDA(At, 0, 1); PG8_STAGE(PG8_SB(0, 0), b2, voffB); PG8_STAGE(PG8_SB(0, 1), b2 + hstep, voffB); PG8_STAGE(PG8_SA(0, 0), a2, voffA);
            PG8_WAIT_V(8); PG8_WAIT_L(0); PG8_BAR; PG8_MMA(1, 0, At, B0); PG8_MMA(1, 1, At, B1); PG8_BAR; PG8_SCHED;
            PG8_LDB(B0, 1, 0); PG8_LDB(B1, 1, 1); PG8_SCHED; PG8_LDA(At, 1, 0); PG8_STAGE(PG8_SA(0, 1), a2 + hstep, voffA);
            PG8_WAIT_V(8); PG8_WAIT_L(0); PG8_BAR; PG8_MMA(0, 0, At, B0); PG8_MMA(0, 1, At, B1); PG8_BAR; PG8_SCHED;
            PG8_LDA(At, 1, 1); PG8_STAGE(PG8_SB(1, 0), b3, voffB); PG8_STAGE(PG8_SB(1, 1), b3 + hstep, voffB); PG8_STAGE(PG8_SA(1, 0), a3, voffA);
            PG8_WAIT_V(8); PG8_WAIT_L(0); PG8_BAR; PG8_MMA(1, 0, At, B0); PG8_MMA(1, 1, At, B1); PG8_BAR; PG8_SCHED;
            } else {
            PG8_LDB(B0, 0, 0); PG8_SCHED; PG8_LDA(At, 0, 0); PG8_STAGE(PG8_SA(1, 1), a1 + hstep, voffA);
            PG8_WAIT_L(8); PG8_BAR; PG8_WAIT_L(0); PG8_MMA(0, 0, At, B0); PG8_BAR; PG8_SCHED;
            PG8_LDB(B1, 0, 1); PG8_STAGE(PG8_SB(0, 0), b2, voffB);
            PG8_BAR; PG8_WAIT_L(0); PG8_MMA(0, 1, At, B1); PG8_BAR;
            PG8_LDA(At, 0, 1); PG8_STAGE(PG8_SA(0, 0), a2, voffA);
            PG8_BAR; PG8_WAIT_L(0); PG8_MMA(1, 0, At, B0); PG8_BAR; PG8_SCHED;
            PG8_STAGE(PG8_SB(0, 1), b2 + hstep, voffB);
            PG8_WAIT_V(6); PG8_BAR; PG8_MMA(1, 1, At, B1); PG8_BAR;
            PG8_LDB(B0, 1, 0); PG8_SCHED; PG8_LDA(At, 1, 0); PG8_STAGE(PG8_SA(0, 1), a2 + hstep, voffA);
            PG8_WAIT_L(8); PG8_BAR; PG8_WAIT_L(0); PG8_MMA(0, 0, At, B0); PG8_BAR; PG8_SCHED;
            PG8_LDB(B1, 1, 1); PG8_STAGE(PG8_SB(1, 0), b3, voffB);
            PG8_BAR; PG8_WAIT_L(0); PG8_MMA(0, 1, At, B1); PG8_BAR;
            PG8_LDA(At, 1, 1); PG8_STAGE(PG8_SA(1, 0), a3, voffA);
            PG8_BAR; PG8_WAIT_L(0); PG8_MMA(1, 0, At, B0); PG8_BAR; PG8_SCHED;
            PG8_STAGE(PG8_SB(1, 1), b3 + hstep, voffB);
            PG8_WAIT_V(6); PG8_BAR; PG8_MMA(1, 1, At, B1); PG8_BAR;
            }
        }
        if constexpr (ALIGN_EPI) { if (wr == 0) PG8_BAR; }
        if constexpr (!Epi::AFTER_DRAIN) { E(acc, cur, wr, wc, fr, fq); S.done(cur); }
        if (!has_next) break;
#pragma unroll
        for (int a = 0; a < 2; ++a)
#pragma unroll
            for (int b = 0; b < 2; ++b)
#pragma unroll
                for (int m = 0; m < 4; ++m)
#pragma unroll
                    for (int n = 0; n < 2; ++n) acc[a][b][m][n] = (f32x4){0.f, 0.f, 0.f, 0.f};
        cur = nxt; cA = nA; cB = nB; ++ui;
        if constexpr (ALIGN_EPI) { if (wr == 1) PG8_BAR; }
    }
    PG8_WAIT_V(0);
    if constexpr (!ALIGN_EPI) { if (wr == 0) PG8_BAR; }
    PG8_BAR;
    if constexpr (Epi::AFTER_DRAIN) { E.fused(acc, cur, wr, wc, fr, fq, lds, wid, lane); S.done(cur); }
#undef PG8_SA
#undef PG8_SB
#undef PG8_STAGE
#undef PG8_LDA
#undef PG8_LDB
#undef PG8_MMA
#undef PG8_WAIT_V
#undef PG8_WAIT_L
#undef PG8_BAR
#undef PG8_SCHED
}
}

DI void transpose_chunk(char* lds, const bf16_t* src_row0, int ld, int colA, int colB, bf16_t* dst  ) {
  const int tid = tid_();
#pragma unroll
  for (int i = 0; i < 2; ++i) {
    int idx = tid + NTHR * i, tok = idx >> 4, ch = idx & 15;
    int col = ch < 8 ? colA + ch * 8 : colB + (ch - 8) * 8;
    u32x4 v = *(const u32x4*)(src_row0 + (size_t)tok * ld + col);
    *(u32x4*)(lds + tok * 272 + ch * 16) = v;
  }
  __syncthreads();
#pragma unroll
  for (int i = 0; i < 2; ++i) {
    int idx = tid + NTHR * i, col = idx >> 3, pc = idx & 7;
    unsigned short v[8];
#pragma unroll
    for (int j = 0; j < 8; ++j) { int tl = 16 * (pc >> 1) + 8 * (j >> 2) + 4 * (pc & 1) + (j & 3); v[j] = *(const unsigned short*)(lds + tl * 272 + col * 2); }
    u32x4 w; w.x = v[0] | ((unsigned)v[1] << 16); w.y = v[2] | ((unsigned)v[3] << 16); w.z = v[4] | ((unsigned)v[5] << 16); w.w = v[6] | ((unsigned)v[7] << 16);
    *(u32x4*)(dst + (size_t)col * KV_ + pc * 8) = w;
  }
  __syncthreads();
}

DI void unpack8(u32x4 r, float (&v)[8]) { v[0] = lo2f(r.x); v[1] = hi2f(r.x); v[2] = lo2f(r.y); v[3] = hi2f(r.y); v[4] = lo2f(r.z); v[5] = hi2f(r.z); v[6] = lo2f(r.w); v[7] = hi2f(r.w); }
DI u32x4 pack8(const float (&v)[8]) { u32x4 w; w.x = pk2(v[0], v[1]); w.y = pk2(v[2], v[3]); w.z = pk2(v[4], v[5]); w.w = pk2(v[6], v[7]); return w; }

DI void norm_rope64(float (&v)[8], const float* gain, int lane, bool rope, const float* tab  , float scale) {
  float ss = 0.f;
#pragma unroll
  for (int e = 0; e < 8; ++e) ss += v[e] * v[e];
  ss += __shfl_xor(ss, 1); ss += __shfl_xor(ss, 2); ss += __shfl_xor(ss, 4);
  const float rstd = rsqrtf(ss * (1.0f / 64.0f) + EPS_);
  const int sl = lane & 7;
  f32x4 g0 = *(const f32x4*)(gain + sl * 8), g1 = *(const f32x4*)(gain + sl * 8 + 4);
  v[0] *= rstd * g0[0]; v[1] *= rstd * g0[1]; v[2] *= rstd * g0[2]; v[3] *= rstd * g0[3];
  v[4] *= rstd * g1[0]; v[5] *= rstd * g1[1]; v[6] *= rstd * g1[2]; v[7] *= rstd * g1[3];
  float pr[8];
#pragma unroll
  for (int e = 0; e < 8; ++e) pr[e] = __shfl_xor(v[e], 2);
  if (rope) {
    const int base = (sl >> 2) * 32 + (sl & 1) * 8;
    const float sgn = (sl & 2) ? 1.0f : -1.0f;
    f32x4 c0 = *(const f32x4*)(tab + base), c1 = *(const f32x4*)(tab + base + 4), s0 = *(const f32x4*)(tab + base + 16), s1 = *(const f32x4*)(tab + base + 20);
#pragma unroll
    for (int e = 0; e < 4; ++e) { v[e] = v[e] * c0[e] + sgn * pr[e] * s0[e]; v[4 + e] = v[4 + e] * c1[e] + sgn * pr[4 + e] * s1[e]; }
  }
#pragma unroll
  for (int e = 0; e < 8; ++e) v[e] *= scale;
}

DI void post_even(const Params& p, char* lds, int i2) {
  const int tid = tid_(), lane = tid & 63, wid = tid >> 6;
  const float qscale = 0.125f * LOG2E;
  for (int row = bid_() * NWV + wid; row < NT; row += gridDim.x * NWV) {
    int b, kpos; row_bk(row, b, kpos);
    const bool lat = row < NLAT;
    const bf16_t* src = p.P + (size_t)row * 2304;
    const float* tab = p.rope64 + (size_t)(lat ? kpos : 0) * 64;
    const int l2 = lane & 15;
    const u32x4 r0 = *(const u32x4*)(src + lane * 8), r1 = *(const u32x4*)(src + 512 + lane * 8), r2 = *(const u32x4*)(src + 1536 + lane * 8), r3 = *(const u32x4*)(src + 2048 + l2 * 8);
    float v[8];
    unpack8(r0, v); norm_rope64(v, p.diff_q_g + i2 * 64, lane, lat, tab, qscale);
    *(u32x4*)(p.Q1 + (size_t)row * 512 + lane * 8) = pack8(v);
    unpack8(r1, v); norm_rope64(v, p.diff_k_g + i2 * 64, lane, lat, tab, 1.0f);
    *(u32x4*)(p.K1 + ((size_t)b * KV_ + kpos) * 512 + lane * 8) = pack8(v);
    unpack8(r2, v); norm_rope64(v, p.swa_q_g + i2 * 64, lane, lat, tab, qscale);
    *(u32x4*)(p.Q2 + (size_t)row * 512 + lane * 8) = pack8(v);
    unpack8(r3, v); norm_rope64(v, p.swa_k_g + i2 * 64, lane, lat, tab, 1.0f);
    if (lane < 16) *(u32x4*)(p.K2 + ((size_t)b * KV_ + kpos) * 128 + l2 * 8) = pack8(v);
  }
  for (int item = bid_(); item < (NT / 64) * 5; item += gridDim.x) {
    const int tile = item / 5, cch = item % 5;
    const int r0 = tile * 64; int b, kpos0; row_bk(r0, b, kpos0);
    const bf16_t* srow = p.P + (size_t)r0 * 2304;
    if (cch < 4) transpose_chunk(lds, srow, 2304, 1024 + cch * 128, 1024 + cch * 128 + 64, p.V1t + (size_t)(b * 512 + cch * 128) * KV_ + kpos0);
    else transpose_chunk(lds, srow, 2304, 2176, 2176 + 64, p.V2t + (size_t)(b * 128) * KV_ + kpos0);
  }
}

DI void post_odd_a(const Params& p, char* lds, int i2) {
  const int tid = tid_(), lane = tid & 63, wid = tid >> 6;
  const float qscale = 0.125f * LOG2E;
  for (int row = bid_() * NWV + wid; row < NT; row += gridDim.x * NWV) {
    int b, kpos; row_bk(row, b, kpos);
    const bf16_t* src = p.P + (size_t)row * 2560;
    const int l2 = lane & 31;
    const u32x4 r0 = *(const u32x4*)(src + lane * 8), r1 = *(const u32x4*)(src + 512 + l2 * 8), r2 = *(const u32x4*)(src + 800 + lane * 8), r3 = *(const u32x4*)(src + 1312 + lane * 8);
    u32x4 rk = {0, 0, 0, 0};
    if (lane >= 32 && lane < 36) rk = *(const u32x4*)(src + 768 + (lane - 32) * 8);
    float v[8];
    {
      unpack8(r0, v);
      float ss = 0.f;
#pragma unroll
      for (int e = 0; e < 8; ++e) ss += v[e] * v[e];
      ss = wave_sum(ss);
      const float rstd = rsqrtf(ss * (1.0f / 512.0f) + EPS_);
      const float* g = p.mla_qa_g + i2 * 512 + lane * 8;
#pragma unroll
      for (int e = 0; e < 8; ++e) v[e] *= rstd * g[e];
      *(u32x4*)(p.QAn + (size_t)row * 512 + lane * 8) = pack8(v);
    }
    {
      unpack8(r1, v);
      float ss = 0.f;
#pragma unroll
      for (int e = 0; e < 8; ++e) ss += v[e] * v[e];
#pragma unroll
      for (int o = 16; o >= 1; o >>= 1) ss += __shfl_xor(ss, o);
      const float rstd = rsqrtf(ss * (1.0f / 256.0f) + EPS_);
      const float* g = p.mla_kva_g + i2 * 256 + l2 * 8;
#pragma unroll
      for (int e = 0; e < 8; ++e) v[e] *= rstd * g[e];
      if (lane < 32) *(u32x4*)(p.KVAn + (size_t)row * 256 + l2 * 8) = pack8(v);
      else if (lane < 36) *(u32x4*)(p.KR + (size_t)row * 32 + (lane - 32) * 8) = rk;
    }
    unpack8(r2, v); norm_rope64(v, p.na_q_g + i2 * 64, lane, false, p.rope64, qscale);
    *(u32x4*)(p.Q2 + (size_t)row * 512 + lane * 8) = pack8(v);
    unpack8(r3, v); norm_rope64(v, p.na_k_g + i2 * 64, lane, false, p.rope64, 1.0f);
    *(u32x4*)(p.K2 + ((size_t)b * KV_ + kpos) * 512 + lane * 8) = pack8(v);
  }
  for (int item = bid_(); item < (NT / 64) * 4; item += gridDim.x) {
    const int tile = item >> 2, cch = item & 3;
    const int r0 = tile * 64; int b, kpos0; row_bk(r0, b, kpos0);
    const bf16_t* srow = p.P + (size_t)r0 * 2560;
    transpose_chunk(lds, srow, 2560, 1824 + cch * 128, 1824 + cch * 128 + 64, p.V2t + (size_t)(b * 512 + cch * 128) * KV_ + kpos0);
  }
}

DI void post_odd_c(const Params& p, char* lds, int i2) {
  const int tid = tid_(), lane = tid & 63, wid = tid >> 6;
  const float qscale = 0.10206207261596575f * LOG2E;
  const int sl = lane & 15, hg = lane >> 4;
  for (int row = bid_() * NWV + wid; row < NT; row += gridDim.x * NWV) {
    int b, kpos; row_bk(row, b, kpos);
    const bool lat = row < NLAT;
    u32x4 raw[4];
#pragma unroll
    for (int chunk = 0; chunk < 4; ++chunk) {
      const int head = (chunk & 1) * 4 + hg;
      raw[chunk] = (u32x4){0, 0, 0, 0};
      if (sl < 12) {
        if (chunk < 2) raw[chunk] = *(const u32x4*)(p.QUP + (size_t)row * 768 + head * 96 + sl * 8);
        else if (sl < 8) raw[chunk] = *(const u32x4*)(p.KVUP + (size_t)row * 1024 + head * 128 + sl * 8);
        else raw[chunk] = *(const u32x4*)(p.KR + (size_t)row * 32 + (sl - 8) * 8);
      }
    }
    f32x4 tc0 = {0, 0, 0, 0}, tc1 = tc0, ts0 = tc0, ts1 = tc0;
    const bool dorope = lat && sl >= 8 && sl < 12;
    if (dorope) { const float* tab = p.rope32 + (size_t)kpos * 32 + ((sl - 8) >> 1) * 16; tc0 = *(const f32x4*)tab; tc1 = *(const f32x4*)(tab + 4); ts0 = *(const f32x4*)(tab + 8); ts1 = *(const f32x4*)(tab + 12); }
#pragma unroll
    for (int chunk = 0; chunk < 4; ++chunk) {
      const int head = (chunk & 1) * 4 + hg;
      const bool isq = chunk < 2;
      float v[8];
      unpack8(raw[chunk], v);
      float ss = 0.f;
#pragma unroll
      for (int e = 0; e < 8; ++e) ss += v[e] * v[e];
      ss += __shfl_xor(ss, 1); ss += __shfl_xor(ss, 2); ss += __shfl_xor(ss, 4); ss += __shfl_xor(ss, 8);
      const float rstd = rsqrtf(ss * (1.0f / 96.0f) + EPS_);
      const float* g = (isq ? p.mla_q_g : p.mla_k_g) + i2 * 96 + (sl < 12 ? sl : 0) * 8;
#pragma unroll
      for (int e = 0; e < 8; ++e) v[e] *= rstd * g[e];
      float pr[8];
#pragma unroll
      for (int e = 0; e < 8; ++e) pr[e] = __shfl_xor(v[e], 1);
      if (dorope) {
        const float sgn = (sl & 1) ? 1.0f : -1.0f;
#pragma unroll
        for (int e = 0; e < 4; ++e) { v[e] = v[e] * tc0[e] + sgn * pr[e] * ts0[e]; v[4 + e] = v[4 + e] * tc1[e] + sgn * pr[4 + e] * ts1[e]; }
      }
      if (sl < 12) {
        if (isq) {
#pragma unroll
          for (int e = 0; e < 8; ++e) v[e] *= qscale;
          *(u32x4*)(p.Q1 + (size_t)row * 768 + head * 96 + sl * 8) = pack8(v);
        } else {
          *(u32x4*)(p.K1 + ((size_t)b * KV_ + kpos) * 768 + head * 96 + sl * 8) = pack8(v);
        }
      }
    }
  }
  for (int item = bid_(); item < (NT / 64) * 4; item += gridDim.x) {
    const int tile = item >> 2, cch = item & 3;
    const int r0 = tile * 64; int b, kpos0; row_bk(r0, b, kpos0);
    const bf16_t* srow = p.KVUP + (size_t)r0 * 1024;
    transpose_chunk(lds, srow, 1024, (2 * cch) * 128 + 64, (2 * cch + 1) * 128 + 64, p.V1t + (size_t)(b * 512 + cch * 128) * KV_ + kpos0);
  }
}

constexpr int ATT_STAGE = 31744;
template <int DQK, int DV, int MODE>
DI void attn_core(char* lds, const bf16_t* Qrow, const bf16_t* Kb, int ldk, const bf16_t* Vtb,
                  int t0a, int na, int t0b, int nb, int qpos, const float* rpbL, float bound,
                  f32x16 (&o)[DV / 32], float& l_out) {
  constexpr int KROW = DQK * 2 + 16, KCH = DQK / 8, NKCH = 64 * KCH, NKC = (NKCH + NTHR - 1) / NTHR, NVC = DV * 8 / NTHR, KS = DQK / 16, NDB = DV / 32;
  const int tid = tid_(), lane = tid & 63, l31 = lane & 31, hi = lane >> 5;
  bf16x8 qf[KS];
#pragma unroll
  for (int kk = 0; kk < KS; ++kk) qf[kk] = *(const bf16x8*)(Qrow + kk * 16 + hi * 8);
#pragma unroll
  for (int db = 0; db < NDB; ++db)
#pragma unroll
    for (int i = 0; i < 16; ++i) o[db][i] = 0.f;
  float l = 0.f;
  f32x16 negb;
#pragma unroll
  for (int i = 0; i < 16; ++i) negb[i] = -bound;
  asm volatile("" : "+v"(negb));
  u32x4 rk0[NKC], rv0[NVC], rk1[NKC], rv1[NVC];
  const int n = na + nb;
  int qrow = 0, qcol = 0, rs = 0, cs = 0;
  if (MODE == 2) { qrow = qpos >> 6; qcol = qpos & 63; rs = min(max(qrow - 4, 0), 120); cs = min(max(qcol - 8, 0), 48); }
  int kr_[NKC], kc_[NKC]; bool kok_[NKC];
#pragma unroll
  for (int i = 0; i < NKC; ++i) { int idx = tid + NTHR * i; kok_[i] = idx < NKCH; if (!kok_[i]) idx = 0; kr_[i] = idx / KCH; kc_[i] = idx % KCH; }
  const int vr_ = tid >> 3, vc_ = tid & 7;
#define ATT_TILE(s_) ((s_) < na ? t0a + (s_) : t0b + ((s_) - na))
#define ATT_GLOAD(RK, RV, kt_) do { \
    _Pragma("unroll") for (int i = 0; i < NKC; ++i) if (kok_[i]) RK[i] = *(const u32x4*)(Kb + (size_t)((kt_) * 64 + kr_[i]) * ldk + kc_[i] * 8); \
    _Pragma("unroll") for (int i = 0; i < NVC; ++i) RV[i] = *(const u32x4*)(Vtb + (size_t)(vr_ + 64 * i) * KV_ + (kt_) * 64 + vc_ * 8); } while (0)
#define ATT_LSTORE(RK, RV, base_) do { \
    _Pragma("unroll") for (int i = 0; i < NKC; ++i) if (kok_[i]) *(u32x4*)((base_) + kr_[i] * KROW + kc_[i] * 16) = RK[i]; \
    _Pragma("unroll") for (int i = 0; i < NVC; ++i) *(u32x4*)((base_) + 64 * KROW + (vr_ + 64 * i) * 144 + vc_ * 16) = RV[i]; } while (0)
  ATT_GLOAD(rk0, rv0, ATT_TILE(0));
  if (n > 1) ATT_GLOAD(rk1, rv1, ATT_TILE(1));
  ATT_LSTORE(rk0, rv0, lds);
  __syncthreads();
  auto step = [&](int s, u32x4 (&ldK)[NKC], u32x4 (&ldV)[NVC], u32x4 (&wrK)[NKC], u32x4 (&wrV)[NVC]) {
    const int kt = ATT_TILE(s);
    char* ldsK = lds + (s & 1) * ATT_STAGE; char* ldsV = ldsK + 64 * KROW;
    char* nx = lds + ((s + 1) & 1) * ATT_STAGE;
    if (s + 2 < n) ATT_GLOAD(ldK, ldV, ATT_TILE(s + 2));
    bool rowok = true; int dr = 0;
    if (MODE == 2) { rowok = (kt >= rs) && (kt < rs + 8); dr = kt - qrow + 7; }
    bool skip = false;
    if (MODE == 2) skip = (kt < 128) && !rowok;
    if (MODE == 1) { const int qmin = qpos - l31; skip = (kt < 128) && ((kt * 64 + 63 < qmin - 128) || (kt * 64 > qmin + 31 + 128)); }
    skip = __builtin_amdgcn_readfirstlane((int)skip) != 0;
    if (!skip)
#pragma unroll
    for (int sub = 0; sub < 2; ++sub) {
      f32x16 sa;
#pragma unroll
      for (int kk = 0; kk < KS; ++kk) {
        bf16x8 kf = *(const bf16x8*)(ldsK + (sub * 32 + l31) * KROW + kk * 32 + hi * 16);
        if (kk == 0) sa = mfma32(kf, qf[kk], negb); else sa = mfma32(kf, qf[kk], sa);
      }
      if (MODE == 1) {
        if (kt < 128) {
#pragma unroll
          for (int i = 0; i < 16; ++i) {
            const int kpos = kt * 64 + sub * 32 + (i & 3) + 8 * (i >> 2) + 4 * hi;
            const int d = kpos - qpos;
            if (d > 128 || d < -128) sa[i] = -INFINITY;
          }
        }
      } else if (MODE == 2) {
        if (kt < 128) {
#pragma unroll
          for (int i = 0; i < 16; ++i) {
            const int kcol = sub * 32 + (i & 3) + 8 * (i >> 2) + 4 * hi;
            const bool ok = rowok && (kcol >= cs) && (kcol < cs + 16);
            const int idx = ok ? dr * 31 + (kcol - qcol + 15) : 0;
            const float bias = rpbL[idx];
            sa[i] = ok ? sa[i] + bias : -INFINITY;
          }
        }
      }
      f32x2 rs2 = {0.f, 0.f};
#pragma unroll
      for (int i = 0; i < 16; i += 2) { f32x2 pv = {ex2(sa[i]), ex2(sa[i + 1])}; sa[i] = pv[0]; sa[i + 1] = pv[1]; rs2 += pv; }
      l += rs2[0] + rs2[1];
      bf16x8 pf[2];
#pragma unroll
      for (int j = 0; j < 2; ++j) {
        u32x4 w;
        w.x = pk2(sa[8 * j + 0], sa[8 * j + 1]); w.y = pk2(sa[8 * j + 2], sa[8 * j + 3]);
        w.z = pk2(sa[8 * j + 4], sa[8 * j + 5]); w.w = pk2(sa[8 * j + 6], sa[8 * j + 7]);
        pf[j] = __builtin_bit_cast(bf16x8, w);
      }
#pragma unroll
      for (int db = 0; db < NDB; ++db)
#pragma unroll
        for (int j = 0; j < 2; ++j) {
          bf16x8 vf = *(const bf16x8*)(ldsV + (db * 32 + l31) * 144 + (sub * 32 + j * 16 + hi * 8) * 2);
          o[db] = mfma32(vf, pf[j], o[db]);
        }
    }
    if (s + 1 < n) ATT_LSTORE(wrK, wrV, nx);
    __syncthreads();
  };
  for (int s = 0; s < n; s += 2) {
    step(s, rk0, rv0, rk1, rv1);
    if (s + 1 < n) step(s + 1, rk1, rv1, rk0, rv0);
  }
#undef ATT_TILE
#undef ATT_GLOAD
#undef ATT_LSTORE
  l_out = l + __shfl_xor(l, 32);
}

DI float logit_bound(const float* gq, const float* gk, int d, float scale) {
  const int lane = tid_() & 63;
  float a = fabsf(gq[lane]), b = fabsf(gk[lane]);
  if (d > 64 && lane < d - 64) { a = fmaxf(a, fabsf(gq[64 + lane])); b = fmaxf(b, fabsf(gk[64 + lane])); }
#pragma unroll
  for (int o = 32; o >= 1; o >>= 1) { a = fmaxf(a, __shfl_xor(a, o)); b = fmaxf(b, __shfl_xor(b, o)); }
  return (float)d * a * b * scale * LOG2E * 1.02f + 0.25f;
}

template <int NDB>
DI void store_o(bf16_t* dst, const f32x16 (&o)[NDB], float sc, int hi) {
#pragma unroll
  for (int db = 0; db < NDB; ++db)
#pragma unroll
    for (int g = 0; g < 4; ++g) {
      u32x2 w; w.x = pk2(o[db][4 * g] * sc, o[db][4 * g + 1] * sc); w.y = pk2(o[db][4 * g + 2] * sc, o[db][4 * g + 3] * sc);
      *(u32x2*)(dst + db * 32 + 8 * g + 4 * hi) = w;
    }
}

DI void unit_A(const Params& p, char* lds, int layer, int b, int h, int qrow0, int t0a, int na, int t0b, int nb) {
  const int i2 = layer >> 1;
  const int tid = tid_(), lane = tid & 63, wid = tid >> 6, l31 = lane & 31, hi = lane >> 5;
  const int qrow = qrow0 + wid * 32 + l31;
  const bf16_t* Vtb = p.V1t + (size_t)(b * 512 + h * 128) * KV_;
  f32x16 o0[4]; float l0;
  const float bound = logit_bound(p.diff_q_g + i2 * 64, p.diff_k_g + i2 * 64, 64, 0.125f);
  f32x4* sp = (f32x4*)(p.spill + ((size_t)bid_() * NTHR + tid) * 64);
  {
    attn_core<64, 128, 0>(lds, p.Q1 + (size_t)qrow * 512 + (h * 2 + 0) * 64, p.K1 + (size_t)b * KV_ * 512 + (h * 2 + 0) * 64, 512, Vtb, t0a, na, t0b, nb, 0, nullptr, bound, o0, l0);
    const float inv0 = 1.0f / l0;
#pragma unroll
    for (int db = 0; db < 4; ++db)
#pragma unroll
      for (int g = 0; g < 4; ++g) { f32x4 t = {o0[db][4 * g] * inv0, o0[db][4 * g + 1] * inv0, o0[db][4 * g + 2] * inv0, o0[db][4 * g + 3] * inv0}; sp[db * 4 + g] = t; }
  }
  attn_core<64, 128, 0>(lds, p.Q1 + (size_t)qrow * 512 + (h * 2 + 1) * 64, p.K1 + (size_t)b * KV_ * 512 + (h * 2 + 1) * 64, 512, Vtb, t0a, na, t0b, nb, 0, nullptr, bound, o0, l0);
  const float* lv = p.diff_lam + i2 * 256;
  float d01 = wave_sum(lv[lane] * lv[64 + lane]), d23 = wave_sum(lv[128 + lane] * lv[192 + lane]);
  const float lam_init = p.lam_init[layer];
  const float lam = expf(d01) - expf(d23) + lam_init;
  const float c1 = lam / l0;
  float ss = 0.f;
#pragma unroll
  for (int db = 0; db < 4; ++db)
#pragma unroll
    for (int g = 0; g < 4; ++g) { f32x4 t = sp[db * 4 + g];
#pragma unroll
      for (int e = 0; e < 4; ++e) { float d = t[e] - c1 * o0[db][4 * g + e]; o0[db][4 * g + e] = d; ss += d * d; } }
  ss += __shfl_xor(ss, 32);
  const float rstd = rsqrtf(ss * (1.0f / 128.0f) + EPS_) * (1.0f - lam_init);
  const float* sg = p.diff_subln_g + i2 * 128;
  bf16_t* dst = p.H + (size_t)qrow * 1024 + h * 128;
#pragma unroll
  for (int db = 0; db < 4; ++db)
#pragma unroll
    for (int g = 0; g < 4; ++g) {
      f32x4 gg = *(const f32x4*)(sg + db * 32 + 8 * g + 4 * hi);
      u32x2 w; w.x = pk2(o0[db][4 * g] * rstd * gg[0], o0[db][4 * g + 1] * rstd * gg[1]); w.y = pk2(o0[db][4 * g + 2] * rstd * gg[2], o0[db][4 * g + 3] * rstd * gg[3]);
      *(u32x2*)(dst + db * 32 + 8 * g + 4 * hi) = w;
    }
}

template <int DQK, int DV, int MODE>
DI void unit_S(const Params& p, char* lds, const bf16_t* Q, int ldq, int qcoloff, const bf16_t* Kb, int ldk, const bf16_t* Vtb,
               int qrow0, int t0a, int na, int t0b, int nb, int qpos0, const float* rpbL, float bound, bool has_sink, float sink2, int ocol) {
  const int tid = tid_(), lane = tid & 63, wid = tid >> 6, l31 = lane & 31, hi = lane >> 5;
  const int qrow = qrow0 + wid * 32 + l31;
  f32x16 o[DV / 32]; float l;
  attn_core<DQK, DV, MODE>(lds, Q + (size_t)qrow * ldq + qcoloff, Kb, ldk, Vtb, t0a, na, t0b, nb, qpos0 + wid * 32 + l31, rpbL, bound, o, l);
  if (has_sink) l += ex2(sink2 - bound);
  store_o<DV / 32>(p.H + (size_t)qrow * 1024 + ocol, o, 1.0f / l, hi);
}

DI void attn_even(const Params& p, char* lds, int layer, bool need_ctx) {
  const int i2 = layer >> 1;
  if ((tid_() >> 6) >= 4) __builtin_amdgcn_s_setprio(1);
  const int nunits = 256 + 512 + (need_ctx ? 24 : 0);
  for (int u = bid_(); u < nunits; u += gridDim.x) {
    const bool isA = (u < 256) || (u >= 768 && u < 776);
    if (isA) {
      int b, h, qrow0, t0, nt;
      if (u < 256) { const int bh = u & 7, qb = u >> 3; b = bh >> 2; h = bh & 3; qrow0 = b * S_ + qb * 256; t0 = 0; nt = 132; }
      else { const int v = u - 768; b = v >> 2; h = v & 3; qrow0 = NLAT + b * 256; t0 = 128; nt = 4; }
      unit_A(p, lds, layer, b, h, qrow0, t0, nt, 0, 0);
    } else {
      int b, hq, qrow0, ta, na, tb, nb, qpos0;
      if (u < 768) { const int v = u - 256, bh = v & 15, qb = v >> 4; b = bh >> 3; hq = bh & 7; qrow0 = b * S_ + qb * 256; qpos0 = qb * 256;
                     ta = max(0, 4 * qb - 2); na = min(128, 4 * qb + 6) - ta; tb = 128; nb = 4; }
      else { const int v = u - 776; b = v >> 3; hq = v & 7; qrow0 = NLAT + b * 256; qpos0 = 0; ta = 128; na = 4; tb = 0; nb = 0; }
      const int kvh = hq >> 2;
      unit_S<64, 64, 1>(p, lds, p.Q2, 512, hq * 64, p.K2 + (size_t)b * KV_ * 128 + kvh * 64, 128, p.V2t + (size_t)(b * 128 + kvh * 64) * KV_,
                        qrow0, ta, na, tb, nb, qpos0, nullptr, logit_bound(p.swa_q_g + i2 * 64, p.swa_k_g + i2 * 64, 64, 0.125f), true, p.swa_sink[i2 * 8 + hq] * LOG2E, 512 + hq * 64);
    }
  }
}

DI void attn_odd(const Params& p, char* lds, int layer, bool need_ctx) {
  const int i2 = layer >> 1;
  if ((tid_() >> 6) >= 4) __builtin_amdgcn_s_setprio(1);
  const int nunits = 512 + 512 + (need_ctx ? 32 : 0);
  float* rpbL = (float*)(lds + 65536);
  for (int u = bid_(); u < nunits; u += gridDim.x) {
    const bool isC = (u < 512) || (u >= 1024 && u < 1040);
    if (isC) {
      int b, h, qrow0, t0, nt;
      if (u < 512) { const int bh = u & 15, qb = u >> 4; b = bh >> 3; h = bh & 7; qrow0 = b * S_ + qb * 256; t0 = 0; nt = 132; }
      else { const int v = u - 1024; b = v >> 3; h = v & 7; qrow0 = NLAT + b * 256; t0 = 128; nt = 4; }
      unit_S<96, 64, 0>(p, lds, p.Q1, 768, h * 96, p.K1 + (size_t)b * KV_ * 768 + h * 96, 768, p.V1t + (size_t)(b * 512 + h * 64) * KV_,
                        qrow0, t0, nt, 0, 0, 0, nullptr, logit_bound(p.mla_q_g + i2 * 96, p.mla_k_g + i2 * 96, 96, 0.10206207261596575f), false, 0.f, h * 64);
    } else {
      int b, h, qrow0, ta, na, tb, nb, qpos0;
      if (u < 1024) { const int v = u - 512, bh = v & 15, qb = v >> 4; b = bh >> 3; h = bh & 7; qrow0 = b * S_ + qb * 256; qpos0 = qb * 256;
                      const int r0 = 4 * qb, r1 = 4 * qb + 3; ta = min(max(r0 - 4, 0), 120); na = min(max(r1 - 4, 0), 120) + 8 - ta; tb = 128; nb = 4; }
      else { const int v = u - 1040; b = v >> 3; h = v & 7; qrow0 = NLAT + b * 256; qpos0 = 0; ta = 128; na = 4; tb = 0; nb = 0; }
      for (int i = tid_(); i < 465; i += NTHR) rpbL[i] = p.na_rpb[(i2 * 8 + h) * 465 + i] * LOG2E;
      float bmax = 0.f;
      for (int i = tid_() & 63; i < 465; i += 64) bmax = fmaxf(bmax, fabsf(p.na_rpb[(i2 * 8 + h) * 465 + i]));
#pragma unroll
      for (int o2 = 32; o2 >= 1; o2 >>= 1) bmax = fmaxf(bmax, __shfl_xor(bmax, o2));
      __syncthreads();
      unit_S<64, 64, 2>(p, lds, p.Q2, 512, h * 64, p.K2 + (size_t)b * KV_ * 512 + h * 64, 512, p.V2t + (size_t)(b * 512 + h * 64) * KV_,
                        qrow0, ta, na, tb, nb, qpos0, rpbL, logit_bound(p.na_q_g + i2 * 64, p.na_k_g + i2 * 64, 64, 0.125f) + bmax * LOG2E, false, 0.f, 512 + h * 64);
    }
  }
}

template <class Epi>
DI void run_gemm(unsigned char* lds, const bf16_t* A, const bf16_t* Bt, int M, int N, int K, const Epi& E) {
  pg8::Gemm g{A, Bt, M, N, K, K};
  pg8::StaticOrder S; S.init(M, N, (int)gridDim.x, bid_());
  pg8::gemm_phase<Epi, pg8::StaticOrder, true, true>((PG8_LAS unsigned char*)lds, g, S, E);
}

template <int NS>
DI void run_gemm_ctx_splitk(unsigned char* lds, const Params& p, const bf16_t* A  , const bf16_t* Bt, int Kfull) {
  const int G = (int)gridDim.x, c = bid_();
  const int slot = G - 1 - c;
  if (slot >= NS * 8) return;
  const int sl = slot >> 3, un = slot & 7;
  const int Kc = Kfull / NS;
  pg8::Gemm g{A + (size_t)NLAT * Kfull + (size_t)sl * Kc, Bt + (size_t)sl * Kc, 512, 1024, Kc, Kfull};
  pg8::StaticOrder S; S.init(512, 1024, 8, un);
  pg8::EpiPartial E{p.part + (size_t)sl * 512 * 1024};
  pg8::gemm_phase<pg8::EpiPartial, pg8::StaticOrder, true, true>((PG8_LAS unsigned char*)lds, g, S, E);
}

template <int layer>
DI void layer_body(const Params& p, char* lds, unsigned char* lds_u, unsigned& gen) {

    const bool need_ctx = layer < 3;
    const int i2 = layer >> 1;
    const int m_res = need_ctx ? NT : NLAT;
    const float* modl = p.mod + layer * 3 * 6144;
    modulate_phase(p, layer, 0, NT, layer > 0 ? 8 : 0, p.mod + ((layer > 0 ? layer - 1 : 0) * 3 + 2) * 6144 + 5120);
    gbar(p.bar, gen);
    if ((layer & 1) == 0) {
      { pg8::EpiStore<0> E{p.P, 2304}; run_gemm(lds_u, p.H, p.wt_in[layer], NT, 2304, 1024, E); }
      gbar(p.bar, gen);
      post_even(p, lds, i2);
      gbar(p.bar, gen);
      attn_even(p, lds, layer, need_ctx);
      __builtin_amdgcn_s_setprio(0);
    } else {
      { pg8::EpiStore<0> E{p.P, 2560}; run_gemm(lds_u, p.H, p.wt_in[layer], NT, 2560, 1024, E); }
      gbar(p.bar, gen);
      post_odd_a(p, lds, i2);
      gbar(p.bar, gen);
      { pg8::EpiStore<0> E{p.QUP, 768}; run_gemm(lds_u, p.QAn, p.wt_qup[i2], NT, 768, 512, E); }
      { pg8::EpiStore<0> E{p.KVUP, 1024}; run_gemm(lds_u, p.KVAn, p.wt_kvup[i2], NT, 1024, 256, E); }
      gbar(p.bar, gen);
      post_odd_c(p, lds, i2);
      gbar(p.bar, gen);
      attn_odd(p, lds, layer, need_ctx);
      __builtin_amdgcn_s_setprio(0);
    }
    gbar(p.bar, gen);
    { pg8::EpiRes E{layer == 0 ? p.x : p.out, p.out, p.xc, modl + 2048}; run_gemm(lds_u, p.H, p.wt_out[layer], NLAT, 1024, 1024, E); }
    if (need_ctx) run_gemm_ctx_splitk<4>(lds_u, p, p.H, p.wt_out[layer], 1024);
    gbar(p.bar, gen);
    modulate_phase(p, layer, 1, m_res, need_ctx ? 4 : 0, modl + 2 * 6144 + 2048);
    gbar(p.bar, gen);
    { pg8::EpiStore<2> E{p.HID, 4096}; run_gemm(lds_u, p.H, p.wt_1[layer], m_res, 4096, 1024, E); }
    gbar(p.bar, gen);
    { pg8::EpiRes E{p.out, p.out, p.xc, modl + 5120}; run_gemm(lds_u, p.HID, p.wt_2[layer], NLAT, 1024, 4096, E); }
    if (need_ctx) run_gemm_ctx_splitk<8>(lds_u, p, p.HID, p.wt_2[layer], 4096);
    gbar(p.bar, gen);
  }
__global__ void __launch_bounds__(NTHR, 2) mega(Params p) {
  extern __shared__ __attribute__((aligned(16))) unsigned char lds_u[];
  char* lds = (char*)lds_u;
  cg::grid_group grid = cg::this_grid();
  phase0(p, lds);
  grid.sync();
  unsigned gen = 0;
  layer_body<0>(p, lds, lds_u, gen);
  layer_body<1>(p, lds, lds_u, gen);
  layer_body<2>(p, lds, lds_u, gen);
  layer_body<3>(p, lds, lds_u, gen);
}

extern "C" void kernel_launch(void* const* d_in, const int* in_sizes, int n_in, void* d_out, int out_size, void* d_ws, size_t ws_size, hipStream_t stream) {
  static int grid_blocks = 0;
  if (!grid_blocks) {
    int dev = 0, cus = 0, per_cu = 0;
    (void)hipGetDevice(&dev);
    (void)hipDeviceGetAttribute(&cus, hipDeviceAttributeMultiprocessorCount, dev);
    (void)hipFuncSetAttribute((const void*)mega, hipFuncAttributeMaxDynamicSharedMemorySize, LDS_BYTES);
    (void)hipOccupancyMaxActiveBlocksPerMultiprocessor(&per_cu, (const void*)mega, NTHR, LDS_BYTES);
    if (per_cu != 1) per_cu = 1;
    grid_blocks = cus * per_cu;
  }
  Params p{};
  const float** pin = (const float**)&p.x;
  for (int i = 0; i < 29; ++i) pin[i] = (const float*)d_in[i];
  p.out = (float*)d_out;
  char* w = (char*)d_ws;
  size_t off = 0;
  auto take = [&](size_t bytes) { char* r = w + off; off += (bytes + 255) & ~(size_t)255; return r; };
  p.bar = (unsigned*)take(256);
  p.xc = (float*)take((size_t)512 * 1024 * 4);
  p.mod = (float*)take((size_t)4 * 3 * 6144 * 4);
  p.rope64 = (float*)take((size_t)S_ * 64 * 4);
  p.rope32 = (float*)take((size_t)S_ * 32 * 4);
  for (int l = 0; l < 4; ++l) {
    p.wt_in[l] = (bf16_t*)take((size_t)2560 * 1024 * 2);
    p.wt_out[l] = (bf16_t*)take((size_t)1024 * 1024 * 2);
    p.wt_1[l] = (bf16_t*)take((size_t)4096 * 1024 * 2);
    p.wt_2[l] = (bf16_t*)take((size_t)4096 * 1024 * 2);
  }
  for (int i = 0; i < 2; ++i) { p.wt_qup[i] = (bf16_t*)take((size_t)768 * 512 * 2); p.wt_kvup[i] = (bf16_t*)take((size_t)1024 * 256 * 2); }
  p.part = (float*)take((size_t)8 * 512 * 1024 * 4);
  p.H = (bf16_t*)take((size_t)NT * 1024 * 2);
  p.KR = (bf16_t*)take((size_t)NT * 32 * 2);
  char* R = take(0);
  size_t roff = 0;
  auto rtake = [&](size_t bytes) { char* r = R + roff; roff += (bytes + 255) & ~(size_t)255; return r; };
  p.P = (bf16_t*)rtake((size_t)NT * 2560 * 2);
  p.Q1 = (bf16_t*)rtake((size_t)NT * 768 * 2);
  p.K1 = (bf16_t*)rtake((size_t)NT * 768 * 2);
  p.V1t = (bf16_t*)rtake((size_t)1024 * KV_ * 2);
  p.Q2 = (bf16_t*)rtake((size_t)NT * 512 * 2);
  p.K2 = (bf16_t*)rtake((size_t)NT * 512 * 2);
  p.V2t = (bf16_t*)rtake((size_t)1024 * KV_ * 2);
  p.HID = (bf16_t*)R;
  p.spill = (float*)p.P;
  p.QUP = p.P;
  p.KVUP = p.P + (size_t)NT * 768;
  p.QAn = p.H;
  p.KVAn = p.H + (size_t)NT * 512;
  int nj = 0, tiles = 0;
  auto add = [&](const float* src, bf16_t* dst, int K, int N, int Npad) {
    WJob& j = p.jobs[nj++]; j.src = src; j.dst = dst; j.K = K; j.N = N; j.Npad = Npad; j.tile0 = tiles; j.ntn = Npad / 128; j.pad_ = 0; tiles += (K / 64) * (Npad / 128);
  };
  for (int l = 0; l < 4; ++l) {
    const int i = l >> 1;
    if ((l & 1) == 0) add(p.ev_w_in + (size_t)i * 1024 * 2304, p.wt_in[l], 1024, 2304, 2304);
    else add(p.od_w_in + (size_t)i * 1024 * 2336, p.wt_in[l], 1024, 2336, 2560);
    add(p.w_out + (size_t)l * 1024 * 1024, p.wt_out[l], 1024, 1024, 1024);
    add(p.mlp_w1 + (size_t)l * 1024 * 4096, p.wt_1[l], 1024, 4096, 4096);
    add(p.mlp_w2 + (size_t)l * 4096 * 1024, p.wt_2[l], 4096, 1024, 1024);
    if (l & 1) {
      add(p.mla_wq_up + (size_t)i * 512 * 768, p.wt_qup[i], 512, 768, 768);
      add(p.mla_wkv_up + (size_t)i * 256 * 1024, p.wt_kvup[i], 256, 1024, 1024);
    }
  }
  p.njobs = nj; p.ntiles_w = tiles;
  for (int j = 0; j < 16; ++j) p.freq64[j] = powf(10000.0f, -(float)j / 16.0f);
  for (int j = 0; j < 8; ++j) p.freq32[j] = powf(10000.0f, -(float)j / 8.0f);
  for (int l = 0; l < 4; ++l) p.lam_init[l] = (float)(0.8 - 0.6 * exp(-0.3 * (double)l));
  (void)hipMemsetAsync(p.bar, 0, 256, stream);
  void* args[] = {&p};
  hipError_t e = hipLaunchCooperativeKernel((void*)mega, dim3(grid_blocks), dim3(NTHR), args, LDS_BYTES, stream);
  if (e != hipSuccess) fprintf(stderr, "cooperative launch failed: %s (grid %d)\n", hipGetErrorString(e), grid_blocks);
}
```

```cpp
#include <hip/hip_runtime.h>
#include <hip/hip_cooperative_groups.h>
#include <cstdio>
#include <cmath>
namespace cg = cooperative_groups;

typedef unsigned short bf16_t;
typedef short bf16x8 __attribute__((ext_vector_type(8)));
typedef float f32x16 __attribute__((ext_vector_type(16)));
typedef float f32x4 __attribute__((ext_vector_type(4)));
typedef float f32x2 __attribute__((ext_vector_type(2)));
typedef unsigned u32x4 __attribute__((ext_vector_type(4)));
typedef unsigned u32x2 __attribute__((ext_vector_type(2)));
typedef __bf16 bf16v2 __attribute__((ext_vector_type(2)));
#define DI __device__ __forceinline__

constexpr int S_ = 8192, D_ = 1024, L_ = 256, NLAT = 2 * S_, NT = NLAT + 2 * L_, KV_ = S_ + L_;
constexpr int LDS_BYTES = 131072;
constexpr int NTHR = 512, NWV = 8;
constexpr float EPS_ = 1e-6f;
constexpr float LOG2E = 1.4426950408889634f;

DI unsigned pk2(float a, float b) { f32x2 v = {a, b}; bf16v2 r = __builtin_convertvector(v, bf16v2); return __builtin_bit_cast(unsigned, r); }
DI float lo2f(unsigned u) { return __uint_as_float(u << 16); }
DI float hi2f(unsigned u) { return __uint_as_float(u & 0xffff0000u); }
DI f32x16 mfma32(bf16x8 a, bf16x8 b, f32x16 c) { return __builtin_amdgcn_mfma_f32_32x32x16_bf16(a, b, c, 0, 0, 0); }
DI float ex2(float x) { return __builtin_amdgcn_exp2f(x); }

struct WJob { const float* src; bf16_t* dst; int K, N, Npad, tile0; int ntn, pad_; };

struct Params {
  const float *x, *c, *ctx, *c_ctx, *ada_w, *ada_b, *norm1_g, *norm2_g, *w_out, *mlp_w1, *mlp_w2,
      *ev_w_in, *diff_q_g, *diff_k_g, *diff_lam, *diff_subln_g, *swa_q_g, *swa_k_g, *swa_sink,
      *od_w_in, *mla_qa_g, *mla_kva_g, *mla_wq_up, *mla_wkv_up, *mla_q_g, *mla_k_g, *na_q_g, *na_k_g, *na_rpb;
  float* out;
  float* xc;
  float* mod;
  float* rope64;
  float* rope32;
  unsigned* bar;
  float* part;
  float* spill;
  bf16_t *wt_in[4], *wt_out[4], *wt_1[4], *wt_2[4], *wt_qup[2], *wt_kvup[2];
  bf16_t *H, *P, *HID, *Q1, *K1, *V1t, *Q2, *K2, *V2t, *QAn, *KVAn, *QUP, *KVUP, *KR;
  WJob jobs[22];
  int njobs, ntiles_w;
  float freq64[16], freq32[8], lam_init[4];
};

DI int tid_() { int t = threadIdx.x; asm volatile("" : "+v"(t)); return t; }
DI int bid_() { int b = blockIdx.x; asm volatile("" : "+s"(b)); return b; }
DI float wave_sum(float v) {
#pragma unroll
  for (int o = 32; o >= 1; o >>= 1) v += __shfl_xor(v, o);
  return v;
}
DI void sincos_d(float x, float& s, float& c) {
  double xd = (double)x;
  double n = rint(xd * 0.15915494309189535);
  double r = xd - n * 6.283185307179586477;
  double r2 = r * r;
  double sp = 1.0 / 51090942171709440000.0;
  sp = sp * (-r2) + 1.0 / 121645100408832000.0;
  sp = sp * (-r2) + 1.0 / 355687428096000.0;
  sp = sp * (-r2) + 1.0 / 1307674368000.0;
  sp = sp * (-r2) + 1.0 / 6227020800.0;
  sp = sp * (-r2) + 1.0 / 39916800.0;
  sp = sp * (-r2) + 1.0 / 362880.0;
  sp = sp * (-r2) + 1.0 / 5040.0;
  sp = sp * (-r2) + 1.0 / 120.0;
  sp = sp * (-r2) + 1.0 / 6.0;
  sp = sp * (-r2) + 1.0;
  double cp = 1.0 / 2432902008176640000.0;
  cp = cp * (-r2) + 1.0 / 6402373705728000.0;
  cp = cp * (-r2) + 1.0 / 20922789888000.0;
  cp = cp * (-r2) + 1.0 / 87178291200.0;
  cp = cp * (-r2) + 1.0 / 479001600.0;
  cp = cp * (-r2) + 1.0 / 3628800.0;
  cp = cp * (-r2) + 1.0 / 40320.0;
  cp = cp * (-r2) + 1.0 / 720.0;
  cp = cp * (-r2) + 1.0 / 24.0;
  cp = cp * (-r2) + 1.0 / 2.0;
  cp = cp * (-r2) + 1.0;
  s = (float)(r * sp);
  c = (float)cp;
}

DI void gbar(unsigned* bar, unsigned& gen) {
  asm volatile("s_waitcnt vmcnt(0)" ::: "memory");
  __syncthreads();
  ++gen;
  if (threadIdx.x == 0) {
    __builtin_amdgcn_fence(__ATOMIC_RELEASE, "agent");
    asm volatile("s_waitcnt vmcnt(0)" ::: "memory");
    __hip_atomic_fetch_add(bar, 1u, __ATOMIC_RELAXED, __HIP_MEMORY_SCOPE_AGENT);
    const unsigned target = gen * gridDim.x;
    while (__hip_atomic_load(bar, __ATOMIC_RELAXED, __HIP_MEMORY_SCOPE_AGENT) < target) __builtin_amdgcn_s_sleep(1);
    __builtin_amdgcn_fence(__ATOMIC_ACQUIRE, "agent");
    asm volatile("s_waitcnt vmcnt(0)" ::: "memory");
  }
  __syncthreads();
}

DI void row_bk(int row, int& b, int& kpos) {
  if (row < NLAT) { b = row >> 13; kpos = row & (S_ - 1); }
  else { int r = row - NLAT; b = r >> 8; kpos = S_ + (r & (L_ - 1)); }
}

DI void phase0(const Params& p, char* lds) {
  const int tid = tid_();
  for (int u = bid_(); u < 384; u += gridDim.x) {
    const int layer = u / 96, chunk = u % 96;
    float* sl = (float*)lds; float* red = (float*)(lds + 12288);
    for (int idx = tid; idx < 3072; idx += NTHR) {
      int m = idx >> 10, k = idx & 1023;
      float v = m < 2 ? p.c[m * 1024 + k] : p.c_ctx[k];
      sl[idx] = v / (1.0f + expf(-v));
    }
    __syncthreads();
    const int cgp = tid & 15, ks = tid >> 4, col = chunk * 64 + cgp * 4;
    f32x4 a0 = {0, 0, 0, 0}, a1 = a0, a2 = a0;
    const float* wp = p.ada_w + ((size_t)layer * 1024 + ks * 32) * 6144 + col;
#pragma unroll 8
    for (int kk = 0; kk < 32; ++kk) {
      f32x4 w = *(const f32x4*)(wp + (size_t)kk * 6144);
      int k = ks * 32 + kk;
      a0 += w * sl[k]; a1 += w * sl[1024 + k]; a2 += w * sl[2048 + k];
    }
    *(f32x4*)(red + (ks * 3 + 0) * 64 + cgp * 4) = a0;
    *(f32x4*)(red + (ks * 3 + 1) * 64 + cgp * 4) = a1;
    *(f32x4*)(red + (ks * 3 + 2) * 64 + cgp * 4) = a2;
    __syncthreads();
    if (tid < 192) {
      int m = tid >> 6, cc = tid & 63;
      float s = p.ada_b[layer * 6144 + chunk * 64 + cc];
#pragma unroll
      for (int k2 = 0; k2 < 32; ++k2) s += red[(k2 * 3 + m) * 64 + cc];
      p.mod[(layer * 3 + m) * 6144 + chunk * 64 + cc] = s;
    }
    __syncthreads();
  }
  {
    float* tile = (float*)lds;
    f32x4 cur[4], nxt[4];
    const int r_ = tid >> 5, c4_ = tid & 31;
    auto locate = [&](int u, WJob& jb, int& kt, int& nt) {
      int j = 0;
      while (j + 1 < p.njobs && u >= p.jobs[j + 1].tile0) ++j;
      jb = p.jobs[j];
      const int t = u - jb.tile0; kt = t / jb.ntn; nt = t % jb.ntn;
    };
    auto gload = [&](f32x4 (&dst)[4], const WJob& jb, int kt, int nt) {
#pragma unroll
      for (int i = 0; i < 4; ++i) {
        const int col = nt * 128 + c4_ * 4;
        dst[i] = (f32x4){0, 0, 0, 0};
        if (col < jb.N) dst[i] = *(const f32x4*)(jb.src + (size_t)(kt * 64 + r_ + 16 * i) * jb.N + col);
      }
    };
    int u = bid_();
    WJob jb; int kt = 0, nt = 0;
    if (u < p.ntiles_w) { locate(u, jb, kt, nt); gload(cur, jb, kt, nt); }
    while (u < p.ntiles_w) {
      const int un = u + (int)gridDim.x;
      WJob jbn = jb; int ktn = 0, ntn = 0;
      if (un < p.ntiles_w) { locate(un, jbn, ktn, ntn); gload(nxt, jbn, ktn, ntn); }
#pragma unroll
      for (int i = 0; i < 4; ++i) {
        float* d = tile + (r_ + 16 * i) * 129 + c4_ * 4;
        d[0] = cur[i][0]; d[1] = cur[i][1]; d[2] = cur[i][2]; d[3] = cur[i][3];
      }
      __syncthreads();
#pragma unroll
      for (int i = 0; i < 2; ++i) {
        const int idx = tid + NTHR * i, n = idx >> 3, kc = idx & 7;
        float v[8];
#pragma unroll
        for (int e = 0; e < 8; ++e) v[e] = tile[(kc * 8 + e) * 129 + n];
        u32x4 w; w.x = pk2(v[0], v[1]); w.y = pk2(v[2], v[3]); w.z = pk2(v[4], v[5]); w.w = pk2(v[6], v[7]);
        *(u32x4*)(jb.dst + (size_t)(nt * 128 + n) * jb.K + kt * 64 + kc * 8) = w;
      }
      __syncthreads();
#pragma unroll
      for (int i = 0; i < 4; ++i) cur[i] = nxt[i];
      jb = jbn; kt = ktn; nt = ntn; u = un;
    }
  }
  const size_t gtid = (size_t)bid_() * NTHR + tid, gsz = (size_t)gridDim.x * NTHR;
  for (size_t i = gtid; i < (size_t)512 * 256; i += gsz) ((f32x4*)p.xc)[i] = ((const f32x4*)p.ctx)[i];
  for (size_t i = gtid; i < (size_t)S_ * 24; i += gsz) {
    int t = (int)(i / 24), j = (int)(i % 24);
    float row = (float)(t >> 6), col = (float)(t & 63);
    float sr, cr, sc, cc;
    if (j < 16) {
      float f = p.freq64[j];
      sincos_d(row * f, sr, cr); sincos_d(col * f, sc, cc);
      float* d = p.rope64 + (size_t)t * 64;
      d[j] = cr; d[16 + j] = sr; d[32 + j] = cc; d[48 + j] = sc;
    } else {
      int jj = j - 16; float f = p.freq32[jj];
      sincos_d(row * f, sr, cr); sincos_d(col * f, sc, cc);
      float* d = p.rope32 + (size_t)t * 32;
      d[jj] = cr; d[8 + jj] = sr; d[16 + jj] = cc; d[24 + jj] = sc;
    }
  }
}

DI void modulate_phase(const Params& p, int layer, int which, int nrows, int nparts, const float* pgate) {
  const int lane = tid_() & 63, wid = tid_() >> 6;
  const float* gn = (which ? p.norm2_g : p.norm1_g) + layer * 1024;
  for (int row = bid_() * NWV + wid; row < nrows; row += gridDim.x * NWV) {
    const int m = row < S_ ? 0 : (row < NLAT ? 1 : 2);
    const float* xr = row < NLAT ? ((layer == 0 && which == 0) ? p.x : p.out) + (size_t)row * 1024 : p.xc + (size_t)(row - NLAT) * 1024;
    const float* md = p.mod + (layer * 3 + m) * 6144 + (which ? 3072 : 0);
    f32x4 v[4]; float ss = 0.f;
#pragma unroll
    for (int i = 0; i < 4; ++i) { v[i] = *(const f32x4*)(xr + i * 256 + lane * 4); ss += v[i][0] * v[i][0] + v[i][1] * v[i][1] + v[i][2] * v[i][2] + v[i][3] * v[i][3]; }
    if (nparts > 0 && row >= NLAT) {
      ss = 0.f;
#pragma unroll
      for (int i = 0; i < 4; ++i) {
        const int c = i * 256 + lane * 4;
        f32x4 acc = {0.f, 0.f, 0.f, 0.f};
        for (int s2 = 0; s2 < nparts; ++s2) acc += *(const f32x4*)(p.part + ((size_t)s2 * 512 + (row - NLAT)) * 1024 + c);
        v[i] += *(const f32x4*)(pgate + c) * acc;
        *(f32x4*)(p.xc + (size_t)(row - NLAT) * 1024 + c) = v[i];
        ss += v[i][0] * v[i][0] + v[i][1] * v[i][1] + v[i][2] * v[i][2] + v[i][3] * v[i][3];
      }
    }
    ss = wave_sum(ss);
    const float rstd = rsqrtf(ss * (1.0f / 1024.0f) + EPS_);
#pragma unroll
    for (int i = 0; i < 4; ++i) {
      const int c = i * 256 + lane * 4;
      f32x4 g = *(const f32x4*)(gn + c), sh = *(const f32x4*)(md + c), sc = *(const f32x4*)(md + 1024 + c);
      f32x4 h = (v[i] * rstd * g) * (sc + 1.0f) + sh;
      u32x2 w; w.x = pk2(h[0], h[1]); w.y = pk2(h[2], h[3]);
      *(u32x2*)(p.H + (size_t)row * 1024 + c) = w;
    }
  }
}

namespace pg8 {
#define PG8_LAS __attribute__((address_space(3)))
typedef unsigned short bf16_t;
typedef short bf16x8 __attribute__((ext_vector_type(8)));
typedef float f32x4 __attribute__((ext_vector_type(4)));
typedef unsigned u32x4 __attribute__((ext_vector_type(4)));
constexpr int BM = 256, BK = 64, HALF = 128, HTB = HALF * BK * 2  , STAGE_BYTES = 8 * HTB, NXCD = 8, WGM = 8;

__host__ __device__ __forceinline__ int lds_byte(int r, int c) { const int st = (r >> 4) * 2 + (c >> 5), rr = r & 15, cc = c & 31, ob = rr * 64 + cc * 2; return st * 1024 + (ob ^ (((ob >> 9) & 1) << 5)); }
__host__ __device__ __forceinline__ void stage_rc(int b, int& R, int& C) { const int st = b / 1024, sb = b % 1024, swz = sb ^ (((sb >> 9) & 1) << 5); R = (st >> 1) * 16 + swz / 64; C = (st & 1) * 32 + (swz % 64) / 2; }
__host__ __device__ __forceinline__ int perm32(int rho) { const int n = rho >> 4, i = rho & 15; return 8 * (i >> 2) + 4 * n + (i & 3); }

struct Unit { int pm, pn; };
struct Gemm { const bf16_t* A; const bf16_t* Bt; int M, N, K, ld; };

struct StaticOrder {
    int nM, nN, nwg, G, c;
    __host__ __device__ void init(int M, int N, int G_, int c_) { nM = M / BM; nN = N / BM; nwg = nM * nN; G = G_; c = c_; }
    __host__ __device__ bool next(int i, Unit& u) const {
        const long L = (long)i * G + c; if (L >= nwg) return false;
        int wgid = (int)L; { const int q = nwg / NXCD, r = nwg % NXCD, xcd = wgid % NXCD, off = wgid / NXCD; wgid = (xcd < r ? xcd * (q + 1) : r * (q + 1) + (xcd - r) * q) + off; }
        const int nig = WGM * nN, gid = wgid / nig, fm = gid * WGM, gsz = (nM - fm) < WGM ? (nM - fm) : WGM;
        u.pm = fm + ((wgid % nig) % gsz); u.pn = (wgid % nig) / gsz; return true;
    }
    __device__ __forceinline__ void a_ready(const Unit&) const {}
    __device__ __forceinline__ void done(const Unit&) const {}
};


typedef float f32x4v __attribute__((ext_vector_type(4)));
template <int ACT> struct EpiStore {
    static constexpr bool PERM = true, AFTER_DRAIN = false;
    bf16_t* O; int ldc;
    __device__ __forceinline__ void operator()(const f32x4 (&acc)[2][2][4][2], const Unit& u, int wr, int wc, int fr, int fq) const {
        const int row0 = u.pm * BM + wr * 64 + fr, col0 = u.pn * BM + wc * 32 + 8 * fq;
#pragma unroll
        for (int ai = 0; ai < 2; ++ai)
#pragma unroll
            for (int m = 0; m < 4; ++m) { bf16_t* rowp = O + (size_t)(row0 + ai * HALF + m * 16) * ldc + col0;
#pragma unroll
                for (int bj = 0; bj < 2; ++bj) { f32x4 v0 = acc[ai][bj][m][0], v1 = acc[ai][bj][m][1];
                    if (ACT == 2) {
#pragma unroll
                        for (int e = 0; e < 4; ++e) { float a = v0[e] > 0.f ? v0[e] : 0.f; v0[e] = a * a; float b = v1[e] > 0.f ? v1[e] : 0.f; v1[e] = b * b; } }
                    u32x4 w; w.x = ::pk2(v0[0], v0[1]); w.y = ::pk2(v0[2], v0[3]); w.z = ::pk2(v1[0], v1[1]); w.w = ::pk2(v1[2], v1[3]);
                    *(u32x4*)(rowp + bj * HALF) = w; } }
    }
};
struct EpiPartial {
    static constexpr bool PERM = false, AFTER_DRAIN = false;
    float* part;
    __device__ __forceinline__ void operator()(const f32x4 (&acc)[2][2][4][2], const Unit& u, int wr, int wc, int fr, int fq) const {
        const int col0 = u.pn * BM + wc * 32 + 4 * fq;
#pragma unroll
        for (int ai = 0; ai < 2; ++ai)
#pragma unroll
            for (int m = 0; m < 4; ++m) { float* pr = part + (size_t)(u.pm * BM + ai * HALF + wr * 64 + m * 16 + fr) * 1024 + col0;
#pragma unroll
                for (int bj = 0; bj < 2; ++bj)
#pragma unroll
                    for (int n = 0; n < 2; ++n) *(f32x4*)(pr + bj * HALF + n * 16) = acc[ai][bj][m][n]; }
    }
};
struct EpiRes {
    static constexpr bool PERM = false, AFTER_DRAIN = false;
    const float* xsrc; float* xlat; float* xctx; const float* gate_base;
    __device__ __forceinline__ void operator()(const f32x4 (&acc)[2][2][4][2], const Unit& u, int wr, int wc, int fr, int fq) const {
        const int mi = u.pm < 32 ? 0 : (u.pm < 64 ? 1 : 2);
        const float* gate = gate_base + mi * 6144;
        const int col0 = u.pn * BM + wc * 32 + 4 * fq;
        f32x4 gv[2][2];
#pragma unroll
        for (int bj = 0; bj < 2; ++bj)
#pragma unroll
            for (int n = 0; n < 2; ++n) gv[bj][n] = *(const f32x4*)(gate + col0 + bj * HALF + n * 16);
#pragma unroll
        for (int ai = 0; ai < 2; ++ai)
#pragma unroll
            for (int m = 0; m < 4; ++m) { const int r = u.pm * BM + ai * HALF + wr * 64 + m * 16 + fr;
                float* xr = r < ::NLAT ? xlat + (size_t)r * 1024 : xctx + (size_t)(r - ::NLAT) * 1024;
                const float* xs = r < ::NLAT ? xsrc + (size_t)r * 1024 : xr;
#pragma unroll
                for (int bj = 0; bj < 2; ++bj)
#pragma unroll
                    for (int n = 0; n < 2; ++n) { const int cc = col0 + bj * HALF + n * 16; f32x4 xv = *(const f32x4*)(xs + cc); xv += gv[bj][n] * acc[ai][bj][m][n]; *(f32x4*)(xr + cc) = xv; } }
    }
};
template <class Epi, class Sched, bool ALIGN_EPI = false, bool SP2 = false>
__device__ __forceinline__ void gemm_phase(PG8_LAS unsigned char* lds, const Gemm g, const Sched& S, const Epi& E) {
    const int tid = ::tid_(), wid = __builtin_amdgcn_readfirstlane(tid >> 6), lane = tid & 63, wr = wid >> 2, wc = wid & 3, fr = lane & 15, fq = lane >> 4;
    const int K = g.ld, nt = g.K / BK;
    unsigned voffA[2], voffB[2];
#pragma unroll
    for (int i = 0; i < 2; ++i) { int R, C; stage_rc(tid * 16 + i * 8192, R, C); const int Rb = Epi::PERM ? ((R & ~31) + perm32(R & 31)) : R;
        voffA[i] = (unsigned)(R * K + C) * 2u; voffB[i] = (unsigned)(Rb * K + C) * 2u; }
    const size_t kstep = (size_t)(BK * 2);
    const size_t hstep = (size_t)HALF * K * 2;
    const size_t tstep = 2 * hstep;
    const unsigned ldsw = (unsigned)wid * 1024u;
    const int aoff = lds_byte(wr * 64 + fr, fq * 8), boff = lds_byte(wc * 32 + fr, fq * 8);
#define PG8_SA(b, h) (((b) * 2 + (h)) * HTB)
#define PG8_SB(b, h) ((4 + (b) * 2 + (h)) * HTB)
#define PG8_STAGE(bufoff, gbase, voff) do { _Pragma("unroll") for (int _i = 0; _i < 2; ++_i) \
        __builtin_amdgcn_global_load_lds((const unsigned*)((const char*)(gbase) + (voff)[_i]), (PG8_LAS unsigned*)(lds + (bufoff) + ldsw + _i * 8192), 16, 0, 0); } while (0)
#define PG8_LDA(dst, b, h) do { _Pragma("unroll") for (int m = 0; m < 4; ++m) _Pragma("unroll") for (int k = 0; k < 2; ++k) dst[m][k] = *(const PG8_LAS bf16x8*)(lds + PG8_SA(b, h) + aoff + m * 2048 + k * 1024); } while (0)
#define PG8_LDB(dst, b, h) do { _Pragma("unroll") for (int n = 0; n < 2; ++n) _Pragma("unroll") for (int k = 0; k < 2; ++k) dst[n][k] = *(const PG8_LAS bf16x8*)(lds + PG8_SB(b, h) + boff + n * 2048 + k * 1024); } while (0)
#define PG8_MMA(ai, bj, At, Bt) do { __builtin_amdgcn_s_setprio(1); _Pragma("unroll") for (int m = 0; m < 4; ++m) _Pragma("unroll") for (int n = 0; n < 2; ++n) _Pragma("unroll") for (int k = 0; k < 2; ++k) \
        acc[ai][bj][m][n] = __builtin_amdgcn_mfma_f32_16x16x32_bf16(Bt[n][k], At[m][k], acc[ai][bj][m][n], 0, 0, 0); __builtin_amdgcn_s_setprio(0); } while (0)
#define PG8_WAIT_V(n) asm volatile("s_waitcnt vmcnt(" #n ")" ::: "memory")
#define PG8_WAIT_L(n) asm volatile("s_waitcnt lgkmcnt(" #n ")" ::: "memory")
#define PG8_BAR __builtin_amdgcn_s_barrier()
#define PG8_SCHED __builtin_amdgcn_sched_barrier(0)
    Unit cur, nxt; int ui = 0;
    if (!S.next(0, cur)) return;
    f32x4 acc[2][2][4][2];
#pragma unroll
    for (int a = 0; a < 2; ++a)
#pragma unroll
        for (int b = 0; b < 2; ++b)
#pragma unroll
            for (int m = 0; m < 4; ++m)
#pragma unroll
                for (int n = 0; n < 2; ++n) acc[a][b][m][n] = (f32x4){0.f, 0.f, 0.f, 0.f};
    bf16x8 At[4][2], B0[2][2], B1[2][2];
    const char* cA = (const char*)g.A + (size_t)cur.pm * tstep; const char* cB = (const char*)g.Bt + (size_t)cur.pn * tstep;
    S.a_ready(cur);
    if constexpr (SP2) {
        PG8_STAGE(PG8_SB(0, 0), cB, voffB); PG8_STAGE(PG8_SB(0, 1), cB + hstep, voffB); PG8_STAGE(PG8_SA(0, 0), cA, voffA); PG8_STAGE(PG8_SA(0, 1), cA + hstep, voffA);
        if (wr == 1) PG8_BAR;
        PG8_WAIT_V(2); PG8_BAR;
        PG8_STAGE(PG8_SB(1, 0), cB + kstep, voffB); PG8_STAGE(PG8_SA(1, 0), cA + kstep, voffA); PG8_STAGE(PG8_SB(1, 1), cB + hstep + kstep, voffB);
        PG8_WAIT_V(6); PG8_BAR;
    } else {
        PG8_STAGE(PG8_SB(0, 0), cB, voffB); PG8_STAGE(PG8_SA(0, 0), cA, voffA); PG8_STAGE(PG8_SB(0, 1), cB + hstep, voffB); PG8_STAGE(PG8_SA(0, 1), cA + hstep, voffA);
        if (wr == 1) PG8_BAR;
        PG8_WAIT_V(4); PG8_BAR;
        PG8_STAGE(PG8_SB(1, 0), cB + kstep, voffB); PG8_STAGE(PG8_SA(1, 0), cA + kstep, voffA); PG8_STAGE(PG8_SB(1, 1), cB + hstep + kstep, voffB);
        PG8_WAIT_V(6); PG8_BAR;
    }
    for (;;) {
        const bool has_next = S.next(ui + 1, nxt);
        const char* nA = has_next ? (const char*)g.A + (size_t)nxt.pm * tstep : cA; const char* nB = has_next ? (const char*)g.Bt + (size_t)nxt.pn * tstep : cB;
        for (int t = 0; t < nt; t += 2) {
            const bool last = (t == nt - 2);
            const char* a1 = cA + (size_t)(t + 1) * kstep;
            const char* a2 = last ? nA : cA + (size_t)(t + 2) * kstep; const char* b2 = last ? nB : cB + (size_t)(t + 2) * kstep;
            const char* a3 = a2 + kstep; const char* b3 = b2 + kstep;
            if (last && has_next) S.a_ready(nxt);
            if constexpr (SP2) {
            PG8_LDB(B0, 0, 0); PG8_LDB(B1, 0, 1); PG8_SCHED; PG8_LDA(At, 0, 0); PG8_STAGE(PG8_SA(1, 1), a1 + hstep, voffA);
            PG8_WAIT_V(8); PG8_WAIT_L(0); PG8_BAR; PG8_MMA(0, 0, At, B0); PG8_MMA(0, 1, At, B1); PG8_BAR; PG8_SCHED;
            PG8_LDA(At, 0, 1); PG8_STAGE(PG8_SB(0, 0), b2, voffB); PG8_STAGE(PG8_SB(0, 1), b2 + hstep, voffB); PG8_STAGE(PG8_SA(0, 0), a2, voffA);
            PG8_WAIT_V(8); PG8_WAIT_L(0); PG8_BAR; PG8_MMA(1, 0, At, B0); PG8_MMA(1, 1, At, B1); PG8_BAR; PG8_SCHED;
            PG8_LDB(B0, 1, 0); PG8_LDB(B1, 1, 1); PG8_SCHED; PG8_LDA(At, 1, 0); PG8_STAGE(PG8_SA(0, 1), a2 + hstep, voffA);
            PG8_WAIT_V(8); PG8_WAIT_L(0); PG8_BAR; PG8_MMA(0, 0, At, B0); PG8_MMA(0, 1, At, B1); PG8_BAR; PG8_SCHED;
            PG8_LDA(At, 1, 1); PG8_STAGE(PG8_SB(1, 0), b3, voffB); PG8_STAGE(PG8_SB(1, 1), b3 + hstep, voffB); PG8_STAGE(PG8_SA(1, 0), a3, voffA);
            PG8_WAIT_V(8); PG8_WAIT_L(0); PG8_BAR; PG8_MMA(1, 0, At, B0); PG8_MMA(1, 1, At, B1); PG8_BAR; PG8_SCHED;
            } else {
            PG8_LDB(B0, 0, 0); PG8_SCHED; PG8_LDA(At, 0, 0); PG8_STAGE(PG8_SA(1, 1), a1 + hstep, voffA);
            PG8_WAIT_L(8); PG8_BAR; PG8_WAIT_L(0); PG8_MMA(0, 0, At, B0); PG8_BAR; PG8_SCHED;
            PG8_LDB(B1, 0, 1); PG8_STAGE(PG8_SB(0, 0), b2, voffB);
            PG8_BAR; PG8_WAIT_L(0); PG8_MMA(0, 1, At, B1); PG8_BAR;
            PG8_LDA(At, 0, 1); PG8_STAGE(PG8_SA(0, 0), a2, voffA);
            PG8_BAR; PG8_WAIT_L(0); PG8_MMA(1, 0, At, B0); PG8_BAR; PG8_SCHED;
            PG8_STAGE(PG8_SB(0, 1), b2 + hstep, voffB);
            PG8_WAIT_V(6); PG8_BAR; PG8_MMA(1, 1, At, B1); PG8_BAR;
            PG8_LDB(B0, 1, 0); PG8_SCHED; PG8_LDA(At, 1, 0); PG8_STAGE(PG8_SA(0, 1), a2 + hstep, voffA);
            PG8_WAIT_L(8); PG8_BAR; PG8_WAIT_L(0); PG8_MMA(0, 0, At, B0); PG8_BAR; PG8_SCHED;
            PG8_LDB(B1, 1, 1); PG8_STAGE(PG8_SB(1, 0), b3, voffB);
            PG8_BAR; PG8_WAIT_L(0); PG8_MMA(0, 1, At, B1); PG8_BAR;
            PG8_LDA(At, 1, 1); PG8_STAGE(PG8_SA(1, 0), a3, voffA);
            PG8_BAR; PG8_WAIT_L(0); PG8_MMA(1, 0, At, B0); PG8_BAR; PG8_SCHED;
            PG8_STAGE(PG8_SB(1, 1), b3 + hstep, voffB);
            PG8_WAIT_V(6); PG8_BAR; PG8_MMA(1, 1, At, B1); PG8_BAR;
            }
        }
        if constexpr (ALIGN_EPI) { if (wr == 0) PG8_BAR; }
        if constexpr (!Epi::AFTER_DRAIN) { E(acc, cur, wr, wc, fr, fq); S.done(cur); }
        if (!has_next) break;
#pragma unroll
        for (int a = 0; a < 2; ++a)
#pragma unroll
            for (int b = 0; b < 2; ++b)
#pragma unroll
                for (int m = 0; m < 4; ++m)
#pragma unroll
                    for (int n = 0; n < 2; ++n) acc[a][b][m][n] = (f32x4){0.f, 0.f, 0.f, 0.f};
        cur = nxt; cA = nA; cB = nB; ++ui;
        if constexpr (ALIGN_EPI) { if (wr == 1) PG8_BAR; }
    }
    PG8_WAIT_V(0);
    if constexpr (!ALIGN_EPI) { if (wr == 0) PG8_BAR; }
    PG8_BAR;
    if constexpr (Epi::AFTER_DRAIN) { E.fused(acc, cur, wr, wc, fr, fq, lds, wid, lane); S.done(cur); }
#undef PG8_SA
#undef PG8_SB
#undef PG8_STAGE
#undef PG8_LDA
#undef PG8_LDB
#undef PG8_MMA
#undef PG8_WAIT_V
#undef PG8_WAIT_L
#undef PG8_BAR
#undef PG8_SCHED
}
}

DI void transpose_chunk(char* lds, const bf16_t* src_row0, int ld, int colA, int colB, bf16_t* dst  ) {
  const int tid = tid_();
#pragma unroll
  for (int i = 0; i < 2; ++i) {
    int idx = tid + NTHR * i, tok = idx >> 4, ch = idx & 15;
    int col = ch < 8 ? colA + ch * 8 : colB + (ch - 8) * 8;
    u32x4 v = *(const u32x4*)(src_row0 + (size_t)tok * ld + col);
    *(u32x4*)(lds + tok * 272 + ch * 16) = v;
  }
  __syncthreads();
#pragma unroll
  for (int i = 0; i < 2; ++i) {
    int idx = tid + NTHR * i, col = idx >> 3, pc = idx & 7;
    unsigned short v[8];
#pragma unroll
    for (int j = 0; j < 8; ++j) { int tl = 16 * (pc >> 1) + 8 * (j >> 2) + 4 * (pc & 1) + (j & 3); v[j] = *(const unsigned short*)(lds + tl * 272 + col * 2); }
    u32x4 w; w.x = v[0] | ((unsigned)v[1] << 16); w.y = v[2] | ((unsigned)v[3] << 16); w.z = v[4] | ((unsigned)v[5] << 16); w.w = v[6] | ((unsigned)v[7] << 16);
    *(u32x4*)(dst + (size_t)col * KV_ + pc * 8) = w;
  }
  __syncthreads();
}

DI void unpack8(u32x4 r, float (&v)[8]) { v[0] = lo2f(r.x); v[1] = hi2f(r.x); v[2] = lo2f(r.y); v[3] = hi2f(r.y); v[4] = lo2f(r.z); v[5] = hi2f(r.z); v[6] = lo2f(r.w); v[7] = hi2f(r.w); }
DI u32x4 pack8(const float (&v)[8]) { u32x4 w; w.x = pk2(v[0], v[1]); w.y = pk2(v[2], v[3]); w.z = pk2(v[4], v[5]); w.w = pk2(v[6], v[7]); return w; }

DI void norm_rope64(float (&v)[8], const float* gain, int lane, bool rope, const float* tab  , float scale) {
  float ss = 0.f;
#pragma unroll
  for (int e = 0; e < 8; ++e) ss += v[e] * v[e];
  ss += __shfl_xor(ss, 1); ss += __shfl_xor(ss, 2); ss += __shfl_xor(ss, 4);
  const float rstd = rsqrtf(ss * (1.0f / 64.0f) + EPS_);
  const int sl = lane & 7;
  f32x4 g0 = *(const f32x4*)(gain + sl * 8), g1 = *(const f32x4*)(gain + sl * 8 + 4);
  v[0] *= rstd * g0[0]; v[1] *= rstd * g0[1]; v[2] *= rstd * g0[2]; v[3] *= rstd * g0[3];
  v[4] *= rstd * g1[0]; v[5] *= rstd * g1[1]; v[6] *= rstd * g1[2]; v[7] *= rstd * g1[3];
  float pr[8];
#pragma unroll
  for (int e = 0; e < 8; ++e) pr[e] = __shfl_xor(v[e], 2);
  if (rope) {
    const int base = (sl >> 2) * 32 + (sl & 1) * 8;
    const float sgn = (sl & 2) ? 1.0f : -1.0f;
    f32x4 c0 = *(const f32x4*)(tab + base), c1 = *(const f32x4*)(tab + base + 4), s0 = *(const f32x4*)(tab + base + 16), s1 = *(const f32x4*)(tab + base + 20);
#pragma unroll
    for (int e = 0; e < 4; ++e) { v[e] = v[e] * c0[e] + sgn * pr[e] * s0[e]; v[4 + e] = v[4 + e] * c1[e] + sgn * pr[4 + e] * s1[e]; }
  }
#pragma unroll
  for (int e = 0; e < 8; ++e) v[e] *= scale;
}

DI void post_even(const Params& p, char* lds, int i2) {
  const int tid = tid_(), lane = tid & 63, wid = tid >> 6;
  const float qscale = 0.125f * LOG2E;
  for (int row = bid_() * NWV + wid; row < NT; row += gridDim.x * NWV) {
    int b, kpos; row_bk(row, b, kpos);
    const bool lat = row < NLAT;
    const bf16_t* src = p.P + (size_t)row * 2304;
    const float* tab = p.rope64 + (size_t)(lat ? kpos : 0) * 64;
    const int l2 = lane & 15;
    const u32x4 r0 = *(const u32x4*)(src + lane * 8), r1 = *(const u32x4*)(src + 512 + lane * 8), r2 = *(const u32x4*)(src + 1536 + lane * 8), r3 = *(const u32x4*)(src + 2048 + l2 * 8);
    float v[8];
    unpack8(r0, v); norm_rope64(v, p.diff_q_g + i2 * 64, lane, lat, tab, qscale);
    *(u32x4*)(p.Q1 + (size_t)row * 512 + lane * 8) = pack8(v);
    unpack8(r1, v); norm_rope64(v, p.diff_k_g + i2 * 64, lane, lat, tab, 1.0f);
    *(u32x4*)(p.K1 + ((size_t)b * KV_ + kpos) * 512 + lane * 8) = pack8(v);
    unpack8(r2, v); norm_rope64(v, p.swa_q_g + i2 * 64, lane, lat, tab, qscale);
    *(u32x4*)(p.Q2 + (size_t)row * 512 + lane * 8) = pack8(v);
    unpack8(r3, v); norm_rope64(v, p.swa_k_g + i2 * 64, lane, lat, tab, 1.0f);
    if (lane < 16) *(u32x4*)(p.K2 + ((size_t)b * KV_ + kpos) * 128 + l2 * 8) = pack8(v);
  }
  for (int item = bid_(); item < (NT / 64) * 5; item += gridDim.x) {
    const int tile = item / 5, cch = item % 5;
    const int r0 = tile * 64; int b, kpos0; row_bk(r0, b, kpos0);
    const bf16_t* srow = p.P + (size_t)r0 * 2304;
    if (cch < 4) transpose_chunk(lds, srow, 2304, 1024 + cch * 128, 1024 + cch * 128 + 64, p.V1t + (size_t)(b * 512 + cch * 128) * KV_ + kpos0);
    else transpose_chunk(lds, srow, 2304, 2176, 2176 + 64, p.V2t + (size_t)(b * 128) * KV_ + kpos0);
  }
}

DI void post_odd_a(const Params& p, char* lds, int i2) {
  const int tid = tid_(), lane = tid & 63, wid = tid >> 6;
  const float qscale = 0.125f * LOG2E;
  for (int row = bid_() * NWV + wid; row < NT; row += gridDim.x * NWV) {
    int b, kpos; row_bk(row, b, kpos);
    const bf16_t* src = p.P + (size_t)row * 2560;
    const int l2 = lane & 31;
    const u32x4 r0 = *(const u32x4*)(src + lane * 8), r1 = *(const u32x4*)(src + 512 + l2 * 8), r2 = *(const u32x4*)(src + 800 + lane * 8), r3 = *(const u32x4*)(src + 1312 + lane * 8);
    u32x4 rk = {0, 0, 0, 0};
    if (lane >= 32 && lane < 36) rk = *(const u32x4*)(src + 768 + (lane - 32) * 8);
    float v[8];
    {
      unpack8(r0, v);
      float ss = 0.f;
#pragma unroll
      for (int e = 0; e < 8; ++e) ss += v[e] * v[e];
      ss = wave_sum(ss);
      const float rstd = rsqrtf(ss * (1.0f / 512.0f) + EPS_);
      const float* g = p.mla_qa_g + i2 * 512 + lane * 8;
#pragma unroll
      for (int e = 0; e < 8; ++e) v[e] *= rstd * g[e];
      *(u32x4*)(p.QAn + (size_t)row * 512 + lane * 8) = pack8(v);
    }
    {
      unpack8(r1, v);
      float ss = 0.f;
#pragma unroll
      for (int e = 0; e < 8; ++e) ss += v[e] * v[e];
#pragma unroll
      for (int o = 16; o >= 1; o >>= 1) ss += __shfl_xor(ss, o);
      const float rstd = rsqrtf(ss * (1.0f / 256.0f) + EPS_);
      const float* g = p.mla_kva_g + i2 * 256 + l2 * 8;
#pragma unroll
      for (int e = 0; e < 8; ++e) v[e] *= rstd * g[e];
      if (lane < 32) *(u32x4*)(p.KVAn + (size_t)row * 256 + l2 * 8) = pack8(v);
      else if (lane < 36) *(u32x4*)(p.KR + (size_t)row * 32 + (lane - 32) * 8) = rk;
    }
    unpack8(r2, v); norm_rope64(v, p.na_q_g + i2 * 64, lane, false, p.rope64, qscale);
    *(u32x4*)(p.Q2 + (size_t)row * 512 + lane * 8) = pack8(v);
    unpack8(r3, v); norm_rope64(v, p.na_k_g + i2 * 64, lane, false, p.rope64, 1.0f);
    *(u32x4*)(p.K2 + ((size_t)b * KV_ + kpos) * 512 + lane * 8) = pack8(v);
  }
  for (int item = bid_(); item < (NT / 64) * 4; item += gridDim.x) {
    const int tile = item >> 2, cch = item & 3;
    const int r0 = tile * 64; int b, kpos0; row_bk(r0, b, kpos0);
    const bf16_t* srow = p.P + (size_t)r0 * 2560;
    transpose_chunk(lds, srow, 2560, 1824 + cch * 128, 1824 + cch * 128 + 64, p.V2t + (size_t)(b * 512 + cch * 128) * KV_ + kpos0);
  }
}

DI void post_odd_c(const Params& p, char* lds, int i2) {
  const int tid = tid_(), lane = tid & 63, wid = tid >> 6;
  const float qscale = 0.10206207261596575f * LOG2E;
  const int sl = lane & 15, hg = lane >> 4;
  for (int row = bid_() * NWV + wid; row < NT; row += gridDim.x * NWV) {
    int b, kpos; row_bk(row, b, kpos);
    const bool lat = row < NLAT;
    u32x4 raw[4];
#pragma unroll
    for (int chunk = 0; chunk < 4; ++chunk) {
      const int head = (chunk & 1) * 4 + hg;
      raw[chunk] = (u32x4){0, 0, 0, 0};
      if (sl < 12) {
        if (chunk < 2) raw[chunk] = *(const u32x4*)(p.QUP + (size_t)row * 768 + head * 96 + sl * 8);
        else if (sl < 8) raw[chunk] = *(const u32x4*)(p.KVUP + (size_t)row * 1024 + head * 128 + sl * 8);
        else raw[chunk] = *(const u32x4*)(p.KR + (size_t)row * 32 + (sl - 8) * 8);
      }
    }
    f32x4 tc0 = {0, 0, 0, 0}, tc1 = tc0, ts0 = tc0, ts1 = tc0;
    const bool dorope = lat && sl >= 8 && sl < 12;
    if (dorope) { const float* tab = p.rope32 + (size_t)kpos * 32 + ((sl - 8) >> 1) * 16; tc0 = *(const f32x4*)tab; tc1 = *(const f32x4*)(tab + 4); ts0 = *(const f32x4*)(tab + 8); ts1 = *(const f32x4*)(tab + 12); }
#pragma unroll
    for (int chunk = 0; chunk < 4; ++chunk) {
      const int head = (chunk & 1) * 4 + hg;
      const bool isq = chunk < 2;
      float v[8];
      unpack8(raw[chunk], v);
      float ss = 0.f;
#pragma unroll
      for (int e = 0; e < 8; ++e) ss += v[e] * v[e];
      ss += __shfl_xor(ss, 1); ss += __shfl_xor(ss, 2); ss += __shfl_xor(ss, 4); ss += __shfl_xor(ss, 8);
      const float rstd = rsqrtf(ss * (1.0f / 96.0f) + EPS_);
      const float* g = (isq ? p.mla_q_g : p.mla_k_g) + i2 * 96 + (sl < 12 ? sl : 0) * 8;
#pragma unroll
      for (int e = 0; e < 8; ++e) v[e] *= rstd * g[e];
      float pr[8];
#pragma unroll
      for (int e = 0; e < 8; ++e) pr[e] = __shfl_xor(v[e], 1);
      if (dorope) {
        const float sgn = (sl & 1) ? 1.0f : -1.0f;
#pragma unroll
        for (int e = 0; e < 4; ++e) { v[e] = v[e] * tc0[e] + sgn * pr[e] * ts0[e]; v[4 + e] = v[4 + e] * tc1[e] + sgn * pr[4 + e] * ts1[e]; }
      }
      if (sl < 12) {
        if (isq) {
#pragma unroll
          for (int e = 0; e < 8; ++e) v[e] *= qscale;
          *(u32x4*)(p.Q1 + (size_t)row * 768 + head * 96 + sl * 8) = pack8(v);
        } else {
          *(u32x4*)(p.K1 + ((size_t)b * KV_ + kpos) * 768 + head * 96 + sl * 8) = pack8(v);
        }
      }
    }
  }
  for (int item = bid_(); item < (NT / 64) * 4; item += gridDim.x) {
    const int tile = item >> 2, cch = item & 3;
    const int r0 = tile * 64; int b, kpos0; row_bk(r0, b, kpos0);
    const bf16_t* srow = p.KVUP + (size_t)r0 * 1024;
    transpose_chunk(lds, srow, 1024, (2 * cch) * 128 + 64, (2 * cch + 1) * 128 + 64, p.V1t + (size_t)(b * 512 + cch * 128) * KV_ + kpos0);
  }
}

constexpr int ATT_STAGE = 31744;
template <int DQK, int DV, int MODE>
DI void attn_core(char* lds, const bf16_t* Qrow, const bf16_t* Kb, int ldk, const bf16_t* Vtb,
                  int t0a, int na, int t0b, int nb, int qpos, const float* rpbL, float bound,
                  f32x16 (&o)[DV / 32], float& l_out) {
  constexpr int KROW = DQK * 2 + 16, KCH = DQK / 8, NKCH = 64 * KCH, NKC = (NKCH + NTHR - 1) / NTHR, NVC = DV * 8 / NTHR, KS = DQK / 16, NDB = DV / 32;
  const int tid = tid_(), lane = tid & 63, l31 = lane & 31, hi = lane >> 5;
  bf16x8 qf[KS];
#pragma unroll
  for (int kk = 0; kk < KS; ++kk) qf[kk] = *(const bf16x8*)(Qrow + kk * 16 + hi * 8);
#pragma unroll
  for (int db = 0; db < NDB; ++db)
#pragma unroll
    for (int i = 0; i < 16; ++i) o[db][i] = 0.f;
  float l = 0.f;
  f32x16 negb;
#pragma unroll
  for (int i = 0; i < 16; ++i) negb[i] = -bound;
  asm volatile("" : "+v"(negb));
  u32x4 rk0[NKC], rv0[NVC], rk1[NKC], rv1[NVC];
  const int n = na + nb;
  int qrow = 0, qcol = 0, rs = 0, cs = 0;
  if (MODE == 2) { qrow = qpos >> 6; qcol = qpos & 63; rs = min(max(qrow - 4, 0), 120); cs = min(max(qcol - 8, 0), 48); }
  int kr_[NKC], kc_[NKC]; bool kok_[NKC];
#pragma unroll
  for (int i = 0; i < NKC; ++i) { int idx = tid + NTHR * i; kok_[i] = idx < NKCH; if (!kok_[i]) idx = 0; kr_[i] = idx / KCH; kc_[i] = idx % KCH; }
  const int vr_ = tid >> 3, vc_ = tid & 7;
#define ATT_TILE(s_) ((s_) < na ? t0a + (s_) : t0b + ((s_) - na))
#define ATT_GLOAD(RK, RV, kt_) do { \
    _Pragma("unroll") for (int i = 0; i < NKC; ++i) if (kok_[i]) RK[i] = *(const u32x4*)(Kb + (size_t)((kt_) * 64 + kr_[i]) * ldk + kc_[i] * 8); \
    _Pragma("unroll") for (int i = 0; i < NVC; ++i) RV[i] = *(const u32x4*)(Vtb + (size_t)(vr_ + 64 * i) * KV_ + (kt_) * 64 + vc_ * 8); } while (0)
#define ATT_LSTORE(RK, RV, base_) do { \
    _Pragma("unroll") for (int i = 0; i < NKC; ++i) if (kok_[i]) *(u32x4*)((base_) + kr_[i] * KROW + kc_[i] * 16) = RK[i]; \
    _Pragma("unroll") for (int i = 0; i < NVC; ++i) *(u32x4*)((base_) + 64 * KROW + (vr_ + 64 * i) * 144 + vc_ * 16) = RV[i]; } while (0)
  ATT_GLOAD(rk0, rv0, ATT_TILE(0));
  if (n > 1) ATT_GLOAD(rk1, rv1, ATT_TILE(1));
  ATT_LSTORE(rk0, rv0, lds);
  __syncthreads();
  auto step = [&](int s, u32x4 (&ldK)[NKC], u32x4 (&ldV)[NVC], u32x4 (&wrK)[NKC], u32x4 (&wrV)[NVC]) {
    const int kt = ATT_TILE(s);
    char* ldsK = lds + (s & 1) * ATT_STAGE; char* ldsV = ldsK + 64 * KROW;
    char* nx = lds + ((s + 1) & 1) * ATT_STAGE;
    if (s + 2 < n) ATT_GLOAD(ldK, ldV, ATT_TILE(s + 2));
    bool rowok = true; int dr = 0;
    if (MODE == 2) { rowok = (kt >= rs) && (kt < rs + 8); dr = kt - qrow + 7; }
    bool skip = false;
    if (MODE == 2) skip = (kt < 128) && !rowok;
    if (MODE == 1) { const int qmin = qpos - l31; skip = (kt < 128) && ((kt * 64 + 63 < qmin - 128) || (kt * 64 > qmin + 31 + 128)); }
    skip = __builtin_amdgcn_readfirstlane((int)skip) != 0;
    if (!skip)
#pragma unroll
    for (int sub = 0; sub < 2; ++sub) {
      f32x16 sa;
#pragma unroll
      for (int kk = 0; kk < KS; ++kk) {
        bf16x8 kf = *(const bf16x8*)(ldsK + (sub * 32 + l31) * KROW + kk * 32 + hi * 16);
        if (kk == 0) sa = mfma32(kf, qf[kk], negb); else sa = mfma32(kf, qf[kk], sa);
      }
      if (MODE == 1) {
        if (kt < 128) {
#pragma unroll
          for (int i = 0; i < 16; ++i) {
            const int kpos = kt * 64 + sub * 32 + (i & 3) + 8 * (i >> 2) + 4 * hi;
            const int d = kpos - qpos;
            if (d > 128 || d < -128) sa[i] = -INFINITY;
          }
        }
      } else if (MODE == 2) {
        if (kt < 128) {
#pragma unroll
          for (int i = 0; i < 16; ++i) {
            const int kcol = sub * 32 + (i & 3) + 8 * (i >> 2) + 4 * hi;
            const bool ok = rowok && (kcol >= cs) && (kcol < cs + 16);
            const int idx = ok ? dr * 31 + (kcol - qcol + 15) : 0;
            const float bias = rpbL[idx];
            sa[i] = ok ? sa[i] + bias : -INFINITY;
          }
        }
      }
      f32x2 rs2 = {0.f, 0.f};
#pragma unroll
      for (int i = 0; i < 16; i += 2) { f32x2 pv = {ex2(sa[i]), ex2(sa[i + 1])}; sa[i] = pv[0]; sa[i + 1] = pv[1]; rs2 += pv; }
      l += rs2[0] + rs2[1];
      bf16x8 pf[2];
#pragma unroll
      for (int j = 0; j < 2; ++j) {
        u32x4 w;
        w.x = pk2(sa[8 * j + 0], sa[8 * j + 1]); w.y = pk2(sa[8 * j + 2], sa[8 * j + 3]);
        w.z = pk2(sa[8 * j + 4], sa[8 * j + 5]); w.w = pk2(sa[8 * j + 6], sa[8 * j + 7]);
        pf[j] = __builtin_bit_cast(bf16x8, w);
      }
#pragma unroll
      for (int db = 0; db < NDB; ++db)
#pragma unroll
        for (int j = 0; j < 2; ++j) {
          bf16x8 vf = *(const bf16x8*)(ldsV + (db * 32 + l31) * 144 + (sub * 32 + j * 16 + hi * 8) * 2);
          o[db] = mfma32(vf, pf[j], o[db]);
        }
    }
    if (s + 1 < n) ATT_LSTORE(wrK, wrV, nx);
    __syncthreads();
  };
  for (int s = 0; s < n; s += 2) {
    step(s, rk0, rv0, rk1, rv1);
    if (s + 1 < n) step(s + 1, rk1, rv1, rk0, rv0);
  }
#undef ATT_TILE
#undef ATT_GLOAD
#undef ATT_LSTORE
  l_out = l + __shfl_xor(l, 32);
}

DI float logit_bound(const float* gq, const float* gk, int d, float scale) {
  const int lane = tid_() & 63;
  float a = fabsf(gq[lane]), b = fabsf(gk[lane]);
  if (d > 64 && lane < d - 64) { a = fmaxf(a, fabsf(gq[64 + lane])); b = fmaxf(b, fabsf(gk[64 + lane])); }
#pragma unroll
  for (int o = 32; o >= 1; o >>= 1) { a = fmaxf(a, __shfl_xor(a, o)); b = fmaxf(b, __shfl_xor(b, o)); }
  return (float)d * a * b * scale * LOG2E * 1.02f + 0.25f;
}

template <int NDB>
DI void store_o(bf16_t* dst, const f32x16 (&o)[NDB], float sc, int hi) {
#pragma unroll
  for (int db = 0; db < NDB; ++db)
#pragma unroll
    for (int g = 0; g < 4; ++g) {
      u32x2 w; w.x = pk2(o[db][4 * g] * sc, o[db][4 * g + 1] * sc); w.y = pk2(o[db][4 * g + 2] * sc, o[db][4 * g + 3] * sc);
      *(u32x2*)(dst + db * 32 + 8 * g + 4 * hi) = w;
    }
}

DI void unit_A(const Params& p, char* lds, int layer, int b, int h, int qrow0, int t0a, int na, int t0b, int nb) {
  const int i2 = layer >> 1;
  const int tid = tid_(), lane = tid & 63, wid = tid >> 6, l31 = lane & 31, hi = lane >> 5;
  const int qrow = qrow0 + wid * 32 + l31;
  const bf16_t* Vtb = p.V1t + (size_t)(b * 512 + h * 128) * KV_;
  f32x16 o0[4]; float l0;
  const float bound = logit_bound(p.diff_q_g + i2 * 64, p.diff_k_g + i2 * 64, 64, 0.125f);
  f32x4* sp = (f32x4*)(p.spill + ((size_t)bid_() * NTHR + tid) * 64);
  {
    attn_core<64, 128, 0>(lds, p.Q1 + (size_t)qrow * 512 + (h * 2 + 0) * 64, p.K1 + (size_t)b * KV_ * 512 + (h * 2 + 0) * 64, 512, Vtb, t0a, na, t0b, nb, 0, nullptr, bound, o0, l0);
    const float inv0 = 1.0f / l0;
#pragma unroll
    for (int db = 0; db < 4; ++db)
#pragma unroll
      for (int g = 0; g < 4; ++g) { f32x4 t = {o0[db][4 * g] * inv0, o0[db][4 * g + 1] * inv0, o0[db][4 * g + 2] * inv0, o0[db][4 * g + 3] * inv0}; sp[db * 4 + g] = t; }
  }
  attn_core<64, 128, 0>(lds, p.Q1 + (size_t)qrow * 512 + (h * 2 + 1) * 64, p.K1 + (size_t)b * KV_ * 512 + (h * 2 + 1) * 64, 512, Vtb, t0a, na, t0b, nb, 0, nullptr, bound, o0, l0);
  const float* lv = p.diff_lam + i2 * 256;
  float d01 = wave_sum(lv[lane] * lv[64 + lane]), d23 = wave_sum(lv[128 + lane] * lv[192 + lane]);
  const float lam_init = p.lam_init[layer];
  const float lam = expf(d01) - expf(d23) + lam_init;
  const float c1 = lam / l0;
  float ss = 0.f;
#pragma unroll
  for (int db = 0; db < 4; ++db)
#pragma unroll
    for (int g = 0; g < 4; ++g) { f32x4 t = sp[db * 4 + g];
#pragma unroll
      for (int e = 0; e < 4; ++e) { float d = t[e] - c1 * o0[db][4 * g + e]; o0[db][4 * g + e] = d; ss += d * d; } }
  ss += __shfl_xor(ss, 32);
  const float rstd = rsqrtf(ss * (1.0f / 128.0f) + EPS_) * (1.0f - lam_init);
  const float* sg = p.diff_subln_g + i2 * 128;
  bf16_t* dst = p.H + (size_t)qrow * 1024 + h * 128;
#pragma unroll
  for (int db = 0; db < 4; ++db)
#pragma unroll
    for (int g = 0; g < 4; ++g) {
      f32x4 gg = *(const f32x4*)(sg + db * 32 + 8 * g + 4 * hi);
      u32x2 w; w.x = pk2(o0[db][4 * g] * rstd * gg[0], o0[db][4 * g + 1] * rstd * gg[1]); w.y = pk2(o0[db][4 * g + 2] * rstd * gg[2], o0[db][4 * g + 3] * rstd * gg[3]);
      *(u32x2*)(dst + db * 32 + 8 * g + 4 * hi) = w;
    }
}

template <int DQK, int DV, int MODE>
DI void unit_S(const Params& p, char* lds, const bf16_t* Q, int ldq, int qcoloff, const bf16_t* Kb, int ldk, const bf16_t* Vtb,
               int qrow0, int t0a, int na, int t0b, int nb, int qpos0, const float* rpbL, float bound, bool has_sink, float sink2, int ocol) {
  const int tid = tid_(), lane = tid & 63, wid = tid >> 6, l31 = lane & 31, hi = lane >> 5;
  const int qrow = qrow0 + wid * 32 + l31;
  f32x16 o[DV / 32]; float l;
  attn_core<DQK, DV, MODE>(lds, Q + (size_t)qrow * ldq + qcoloff, Kb, ldk, Vtb, t0a, na, t0b, nb, qpos0 + wid * 32 + l31, rpbL, bound, o, l);
  if (has_sink) l += ex2(sink2 - bound);
  store_o<DV / 32>(p.H + (size_t)qrow * 1024 + ocol, o, 1.0f / l, hi);
}

DI void attn_even(const Params& p, char* lds, int layer, bool need_ctx) {
  const int i2 = layer >> 1;
  if ((tid_() >> 6) >= 4) __builtin_amdgcn_s_setprio(1);
  const int nunits = 256 + 512 + (need_ctx ? 24 : 0);
  for (int u = bid_(); u < nunits; u += gridDim.x) {
    const bool isA = (u < 256) || (u >= 768 && u < 776);
    if (isA) {
      int b, h, qrow0, t0, nt;
      if (u < 256) { const int bh = u & 7, qb = u >> 3; b = bh >> 2; h = bh & 3; qrow0 = b * S_ + qb * 256; t0 = 0; nt = 132; }
      else { const int v = u - 768; b = v >> 2; h = v & 3; qrow0 = NLAT + b * 256; t0 = 128; nt = 4; }
      unit_A(p, lds, layer, b, h, qrow0, t0, nt, 0, 0);
    } else {
      int b, hq, qrow0, ta, na, tb, nb, qpos0;
      if (u < 768) { const int v = u - 256, bh = v & 15, qb = v >> 4; b = bh >> 3; hq = bh & 7; qrow0 = b * S_ + qb * 256; qpos0 = qb * 256;
                     ta = max(0, 4 * qb - 2); na = min(128, 4 * qb + 6) - ta; tb = 128; nb = 4; }
      else { const int v = u - 776; b = v >> 3; hq = v & 7; qrow0 = NLAT + b * 256; qpos0 = 0; ta = 128; na = 4; tb = 0; nb = 0; }
      const int kvh = hq >> 2;
      unit_S<64, 64, 1>(p, lds, p.Q2, 512, hq * 64, p.K2 + (size_t)b * KV_ * 128 + kvh * 64, 128, p.V2t + (size_t)(b * 128 + kvh * 64) * KV_,
                        qrow0, ta, na, tb, nb, qpos0, nullptr, logit_bound(p.swa_q_g + i2 * 64, p.swa_k_g + i2 * 64, 64, 0.125f), true, p.swa_sink[i2 * 8 + hq] * LOG2E, 512 + hq * 64);
    }
  }
}

DI void attn_odd(const Params& p, char* lds, int layer, bool need_ctx) {
  const int i2 = layer >> 1;
  if ((tid_() >> 6) >= 4) __builtin_amdgcn_s_setprio(1);
  const int nunits = 512 + 512 + (need_ctx ? 32 : 0);
  float* rpbL = (float*)(lds + 65536);
  for (int u = bid_(); u < nunits; u += gridDim.x) {
    const bool isC = (u < 512) || (u >= 1024 && u < 1040);
    if (isC) {
      int b, h, qrow0, t0, nt;
      if (u < 512) { const int bh = (u & 7) + 8 * (u >> 8), qb = (u >> 3) & 31; b = bh >> 3; h = bh & 7; qrow0 = b * S_ + qb * 256; t0 = 0; nt = 132; }
      else { const int v = u - 1024; b = v >> 3; h = v & 7; qrow0 = NLAT + b * 256; t0 = 128; nt = 4; }
      unit_S<96, 64, 0>(p, lds, p.Q1, 768, h * 96, p.K1 + (size_t)b * KV_ * 768 + h * 96, 768, p.V1t + (size_t)(b * 512 + h * 64) * KV_,
                        qrow0, t0, nt, 0, 0, 0, nullptr, logit_bound(p.mla_q_g + i2 * 96, p.mla_k_g + i2 * 96, 96, 0.10206207261596575f), false, 0.f, h * 64);
    } else {
      int b, h, qrow0, ta, na, tb, nb, qpos0;
      if (u < 1024) { const int v = u - 512, bh = v & 15, qb = v >> 4; b = bh >> 3; h = bh & 7; qrow0 = b * S_ + qb * 256; qpos0 = qb * 256;
                      const int r0 = 4 * qb, r1 = 4 * qb + 3; ta = min(max(r0 - 4, 0), 120); na = min(max(r1 - 4, 0), 120) + 8 - ta; tb = 128; nb = 4; }
      else { const int v = u - 1040; b = v >> 3; h = v & 7; qrow0 = NLAT + b * 256; qpos0 = 0; ta = 128; na = 4; tb = 0; nb = 0; }
      for (int i = tid_(); i < 465; i += NTHR) rpbL[i] = p.na_rpb[(i2 * 8 + h) * 465 + i] * LOG2E;
      float bmax = 0.f;
      for (int i = tid_() & 63; i < 465; i += 64) bmax = fmaxf(bmax, fabsf(p.na_rpb[(i2 * 8 + h) * 465 + i]));
#pragma unroll
      for (int o2 = 32; o2 >= 1; o2 >>= 1) bmax = fmaxf(bmax, __shfl_xor(bmax, o2));
      __syncthreads();
      unit_S<64, 64, 2>(p, lds, p.Q2, 512, h * 64, p.K2 + (size_t)b * KV_ * 512 + h * 64, 512, p.V2t + (size_t)(b * 512 + h * 64) * KV_,
                        qrow0, ta, na, tb, nb, qpos0, rpbL, logit_bound(p.na_q_g + i2 * 64, p.na_k_g + i2 * 64, 64, 0.125f) + bmax * LOG2E, false, 0.f, 512 + h * 64);
    }
  }
}

template <class Epi>
DI void run_gemm(unsigned char* lds, const bf16_t* A, const bf16_t* Bt, int M, int N, int K, const Epi& E) {
  pg8::Gemm g{A, Bt, M, N, K, K};
  pg8::StaticOrder S; S.init(M, N, (int)gridDim.x, bid_());
  pg8::gemm_phase<Epi, pg8::StaticOrder, true, true>((PG8_LAS unsigned char*)lds, g, S, E);
}

template <int NS>
DI void run_gemm_ctx_splitk(unsigned char* lds, const Params& p, const bf16_t* A  , const bf16_t* Bt, int Kfull) {
  const int G = (int)gridDim.x, c = bid_();
  const int slot = G - 1 - c;
  if (slot >= NS * 8) return;
  const int sl = slot >> 3, un = slot & 7;
  const int Kc = Kfull / NS;
  pg8::Gemm g{A + (size_t)NLAT * Kfull + (size_t)sl * Kc, Bt + (size_t)sl * Kc, 512, 1024, Kc, Kfull};
  pg8::StaticOrder S; S.init(512, 1024, 8, un);
  pg8::EpiPartial E{p.part + (size_t)sl * 512 * 1024};
  pg8::gemm_phase<pg8::EpiPartial, pg8::StaticOrder, true, true>((PG8_LAS unsigned char*)lds, g, S, E);
}

template <int layer>
DI void layer_body(const Params& p, char* lds, unsigned char* lds_u, unsigned& gen) {

    const bool need_ctx = layer < 3;
    const int i2 = layer >> 1;
    const int m_res = need_ctx ? NT : NLAT;
    const float* modl = p.mod + layer * 3 * 6144;
    modulate_phase(p, layer, 0, NT, layer > 0 ? 8 : 0, p.mod + ((layer > 0 ? layer - 1 : 0) * 3 + 2) * 6144 + 5120);
    gbar(p.bar, gen);
    if ((layer & 1) == 0) {
      { pg8::EpiStore<0> E{p.P, 2304}; run_gemm(lds_u, p.H, p.wt_in[layer], NT, 2304, 1024, E); }
      gbar(p.bar, gen);
      post_even(p, lds, i2);
      gbar(p.bar, gen);
      attn_even(p, lds, layer, need_ctx);
      __builtin_amdgcn_s_setprio(0);
    } else {
      { pg8::EpiStore<0> E{p.P, 2560}; run_gemm(lds_u, p.H, p.wt_in[layer], NT, 2560, 1024, E); }
      gbar(p.bar, gen);
      post_odd_a(p, lds, i2);
      gbar(p.bar, gen);
      { pg8::EpiStore<0> E{p.QUP, 768}; run_gemm(lds_u, p.QAn, p.wt_qup[i2], NT, 768, 512, E); }
      { pg8::EpiStore<0> E{p.KVUP, 1024}; run_gemm(lds_u, p.KVAn, p.wt_kvup[i2], NT, 1024, 256, E); }
      gbar(p.bar, gen);
      post_odd_c(p, lds, i2);
      gbar(p.bar, gen);
      attn_odd(p, lds, layer, need_ctx);
      __builtin_amdgcn_s_setprio(0);
    }
    gbar(p.bar, gen);
    { pg8::EpiRes E{layer == 0 ? p.x : p.out, p.out, p.xc, modl + 2048}; run_gemm(lds_u, p.H, p.wt_out[layer], NLAT, 1024, 1024, E); }
    if (need_ctx) run_gemm_ctx_splitk<4>(lds_u, p, p.H, p.wt_out[layer], 1024);
    gbar(p.bar, gen);
    modulate_phase(p, layer, 1, m_res, need_ctx ? 4 : 0, modl + 2 * 6144 + 2048);
    gbar(p.bar, gen);
    { pg8::EpiStore<2> E{p.HID, 4096}; run_gemm(lds_u, p.H, p.wt_1[layer], m_res, 4096, 1024, E); }
    gbar(p.bar, gen);
    { pg8::EpiRes E{p.out, p.out, p.xc, modl + 5120}; run_gemm(lds_u, p.HID, p.wt_2[layer], NLAT, 1024, 4096, E); }
    if (need_ctx) run_gemm_ctx_splitk<8>(lds_u, p, p.HID, p.wt_2[layer], 4096);
    gbar(p.bar, gen);
  }
__global__ void __launch_bounds__(NTHR, 2) mega(Params p) {
  extern __shared__ __attribute__((aligned(16))) unsigned char lds_u[];
  char* lds = (char*)lds_u;
  cg::grid_group grid = cg::this_grid();
  phase0(p, lds);
  grid.sync();
  unsigned gen = 0;
  layer_body<0>(p, lds, lds_u, gen);
  layer_body<1>(p, lds, lds_u, gen);
  layer_body<2>(p, lds, lds_u, gen);
  layer_body<3>(p, lds, lds_u, gen);
}

extern "C" void kernel_launch(void* const* d_in, const int* in_sizes, int n_in, void* d_out, int out_size, void* d_ws, size_t ws_size, hipStream_t stream) {
  static int grid_blocks = 0;
  if (!grid_blocks) {
    int dev = 0, cus = 0, per_cu = 0;
    (void)hipGetDevice(&dev);
    (void)hipDeviceGetAttribute(&cus, hipDeviceAttributeMultiprocessorCount, dev);
    (void)hipFuncSetAttribute((const void*)mega, hipFuncAttributeMaxDynamicSharedMemorySize, LDS_BYTES);
    (void)hipOccupancyMaxActiveBlocksPerMultiprocessor(&per_cu, (const void*)mega, NTHR, LDS_BYTES);
    if (per_cu != 1) per_cu = 1;
    grid_blocks = cus * per_cu;
  }
  Params p{};
  const float** pin = (const float**)&p.x;
  for (int i = 0; i < 29; ++i) pin[i] = (const float*)d_in[i];
  p.out = (float*)d_out;
  char* w = (char*)d_ws;
  size_t off = 0;
  auto take = [&](size_t bytes) { char* r = w + off; off += (bytes + 255) & ~(size_t)255; return r; };
  p.bar = (unsigned*)take(256);
  p.xc = (float*)take((size_t)512 * 1024 * 4);
  p.mod = (float*)take((size_t)4 * 3 * 6144 * 4);
  p.rope64 = (float*)take((size_t)S_ * 64 * 4);
  p.rope32 = (float*)take((size_t)S_ * 32 * 4);
  for (int l = 0; l < 4; ++l) {
    p.wt_in[l] = (bf16_t*)take((size_t)2560 * 1024 * 2);
    p.wt_out[l] = (bf16_t*)take((size_t)1024 * 1024 * 2);
    p.wt_1[l] = (bf16_t*)take((size_t)4096 * 1024 * 2);
    p.wt_2[l] = (bf16_t*)take((size_t)4096 * 1024 * 2);
  }
  for (int i = 0; i < 2; ++i) { p.wt_qup[i] = (bf16_t*)take((size_t)768 * 512 * 2); p.wt_kvup[i] = (bf16_t*)take((size_t)1024 * 256 * 2); }
  p.part = (float*)take((size_t)8 * 512 * 1024 * 4);
  p.H = (bf16_t*)take((size_t)NT * 1024 * 2);
  p.KR = (bf16_t*)take((size_t)NT * 32 * 2);
  char* R = take(0);
  size_t roff = 0;
  auto rtake = [&](size_t bytes) { char* r = R + roff; roff += (bytes + 255) & ~(size_t)255; return r; };
  p.P = (bf16_t*)rtake((size_t)NT * 2560 * 2);
  p.Q1 = (bf16_t*)rtake((size_t)NT * 768 * 2);
  p.K1 = (bf16_t*)rtake((size_t)NT * 768 * 2);
  p.V1t = (bf16_t*)rtake((size_t)1024 * KV_ * 2);
  p.Q2 = (bf16_t*)rtake((size_t)NT * 512 * 2);
  p.K2 = (bf16_t*)rtake((size_t)NT * 512 * 2);
  p.V2t = (bf16_t*)rtake((size_t)1024 * KV_ * 2);
  p.HID = (bf16_t*)R;
  p.spill = (float*)p.P;
  p.QUP = p.P;
  p.KVUP = p.P + (size_t)NT * 768;
  p.QAn = p.H;
  p.KVAn = p.H + (size_t)NT * 512;
  int nj = 0, tiles = 0;
  auto add = [&](const float* src, bf16_t* dst, int K, int N, int Npad) {
    WJob& j = p.jobs[nj++]; j.src = src; j.dst = dst; j.K = K; j.N = N; j.Npad = Npad; j.tile0 = tiles; j.ntn = Npad / 128; j.pad_ = 0; tiles += (K / 64) * (Npad / 128);
  };
  for (int l = 0; l < 4; ++l) {
    const int i = l >> 1;
    if ((l & 1) == 0) add(p.ev_w_in + (size_t)i * 1024 * 2304, p.wt_in[l], 1024, 2304, 2304);
    else add(p.od_w_in + (size_t)i * 1024 * 2336, p.wt_in[l], 1024, 2336, 2560);
    add(p.w_out + (size_t)l * 1024 * 1024, p.wt_out[l], 1024, 1024, 1024);
    add(p.mlp_w1 + (size_t)l * 1024 * 4096, p.wt_1[l], 1024, 4096, 4096);
    add(p.mlp_w2 + (size_t)l * 4096 * 1024, p.wt_2[l], 4096, 1024, 1024);
    if (l & 1) {
      add(p.mla_wq_up + (size_t)i * 512 * 768, p.wt_qup[i], 512, 768, 768);
      add(p.mla_wkv_up + (size_t)i * 256 * 1024, p.wt_kvup[i], 256, 1024, 1024);
    }
  }
  p.njobs = nj; p.ntiles_w = tiles;
  for (int j = 0; j < 16; ++j) p.freq64[j] = powf(10000.0f, -(float)j / 16.0f);
  for (int j = 0; j < 8; ++j) p.freq32[j] = powf(10000.0f, -(float)j / 8.0f);
  for (int l = 0; l < 4; ++l) p.lam_init[l] = (float)(0.8 - 0.6 * exp(-0.3 * (double)l));
  (void)hipMemsetAsync(p.bar, 0, 256, stream);
  void* args[] = {&p};
  hipError_t e = hipLaunchCooperativeKernel((void*)mega, dim3(grid_blocks), dim3(NTHR), args, LDS_BYTES, stream);
  if (e != hipSuccess) fprintf(stderr, "cooperative launch failed: %s (grid %d)\n", hipGetErrorString(e), grid_blocks);
}
```

```cpp
#include <hip/hip_runtime.h>
#include <hip/hip_cooperative_groups.h>
#include <cstdio>
#include <cmath>
namespace cg = cooperative_groups;

typedef unsigned short bf16_t;
typedef short bf16x8 __attribute__((ext_vector_type(8)));
typedef float f32x16 __attribute__((ext_vector_type(16)));
typedef float f32x4 __attribute__((ext_vector_type(4)));
typedef float f32x2 __attribute__((ext_vector_type(2)));
typedef unsigned u32x4 __attribute__((ext_vector_type(4)));
typedef unsigned u32x2 __attribute__((ext_vector_type(2)));
typedef __bf16 bf16v2 __attribute__((ext_vector_type(2)));
#define DI __device__ __forceinline__

constexpr int S_ = 8192, D_ = 1024, L_ = 256, NLAT = 2 * S_, NT = NLAT + 2 * L_, KV_ = S_ + L_;
constexpr int LDS_BYTES = 131072;
constexpr int NTHR = 512, NWV = 8;
constexpr float EPS_ = 1e-6f;
constexpr float LOG2E = 1.4426950408889634f;

DI unsigned pk2(float a, float b) { f32x2 v = {a, b}; bf16v2 r = __builtin_convertvector(v, bf16v2); return __builtin_bit_cast(unsigned, r); }
DI float lo2f(unsigned u) { return __uint_as_float(u << 16); }
DI float hi2f(unsigned u) { return __uint_as_float(u & 0xffff0000u); }
DI f32x16 mfma32(bf16x8 a, bf16x8 b, f32x16 c) { return __builtin_amdgcn_mfma_f32_32x32x16_bf16(a, b, c, 0, 0, 0); }
DI float ex2(float x) { return __builtin_amdgcn_exp2f(x); }

struct WJob { const float* src; bf16_t* dst; int K, N, Npad, tile0; int ntn, pad_; };

struct Params {
  const float *x, *c, *ctx, *c_ctx, *ada_w, *ada_b, *norm1_g, *norm2_g, *w_out, *mlp_w1, *mlp_w2,
      *ev_w_in, *diff_q_g, *diff_k_g, *diff_lam, *diff_subln_g, *swa_q_g, *swa_k_g, *swa_sink,
      *od_w_in, *mla_qa_g, *mla_kva_g, *mla_wq_up, *mla_wkv_up, *mla_q_g, *mla_k_g, *na_q_g, *na_k_g, *na_rpb;
  float* out;
  float* xc;
  float* mod;
  float* rope64;
  float* rope32;
  unsigned* bar;
  float* part;
  float* spill;
  bf16_t *wt_in[4], *wt_out[4], *wt_1[4], *wt_2[4], *wt_qup[2], *wt_kvup[2];
  bf16_t *H, *P, *HID, *Q1, *K1, *V1t, *Q2, *K2, *V2t, *QAn, *KVAn, *QUP, *KVUP, *KR;
  WJob jobs[22];
  int njobs, ntiles_w;
  float freq64[16], freq32[8], lam_init[4];
};

DI int tid_() { int t = threadIdx.x; asm volatile("" : "+v"(t)); return t; }
DI int bid_() { int b = blockIdx.x; asm volatile("" : "+s"(b)); return b; }
DI float wave_sum(float v) {
#pragma unroll
  for (int o = 32; o >= 1; o >>= 1) v += __shfl_xor(v, o);
  return v;
}
DI void sincos_d(float x, float& s, float& c) {
  double xd = (double)x;
  double n = rint(xd * 0.15915494309189535);
  double r = xd - n * 6.283185307179586477;
  double r2 = r * r;
  double sp = 1.0 / 51090942171709440000.0;
  sp = sp * (-r2) + 1.0 / 121645100408832000.0;
  sp = sp * (-r2) + 1.0 / 355687428096000.0;
  sp = sp * (-r2) + 1.0 / 1307674368000.0;
  sp = sp * (-r2) + 1.0 / 6227020800.0;
  sp = sp * (-r2) + 1.0 / 39916800.0;
  sp = sp * (-r2) + 1.0 / 362880.0;
  sp = sp * (-r2) + 1.0 / 5040.0;
  sp = sp * (-r2) + 1.0 / 120.0;
  sp = sp * (-r2) + 1.0 / 6.0;
  sp = sp * (-r2) + 1.0;
  double cp = 1.0 / 2432902008176640000.0;
  cp = cp * (-r2) + 1.0 / 6402373705728000.0;
  cp = cp * (-r2) + 1.0 / 20922789888000.0;
  cp = cp * (-r2) + 1.0 / 87178291200.0;
  cp = cp * (-r2) + 1.0 / 479001600.0;
  cp = cp * (-r2) + 1.0 / 3628800.0;
  cp = cp * (-r2) + 1.0 / 40320.0;
  cp = cp * (-r2) + 1.0 / 720.0;
  cp = cp * (-r2) + 1.0 / 24.0;
  cp = cp * (-r2) + 1.0 / 2.0;
  cp = cp * (-r2) + 1.0;
  s = (float)(r * sp);
  c = (float)cp;
}

#define XB_TMO      128
#define XB_XCNT(j)  (256  + 64 * (j))
#define XB_XSUB(j)  (1280 + 64 * (j))
#define XB_XGEN(j)  (2304 + 64 * (j))
#define XB_TOP      3328
#define XB_TOPGEN   3392
#define XCD_BAR_WORDS 3456
#define XB_SPIN_CAP (1u << 18)
#define LAS __attribute__((address_space(3)))

__device__ __forceinline__ unsigned xb_ld(unsigned* p)              { return __hip_atomic_load(p, __ATOMIC_RELAXED, __HIP_MEMORY_SCOPE_AGENT); }
__device__ __forceinline__ unsigned xb_add(unsigned* p, unsigned v) { return __hip_atomic_fetch_add(p, v, __ATOMIC_RELAXED, __HIP_MEMORY_SCOPE_AGENT); }
__device__ __forceinline__ unsigned xb_xcc_id() { return (unsigned)__builtin_amdgcn_s_getreg((3 << 11) | 20) & 0xFu; }
#define XB_SPIN(cond, bar) do { unsigned _sp = 0; while (cond) { __builtin_amdgcn_s_sleep(1); \
    if ((++_sp & 255u) == 0u) { if (xb_ld(&(bar)[XB_TMO])) break; if (_sp > XB_SPIN_CAP) { atomicAdd(&(bar)[XB_TMO], 1u); break; } } } } while (0)

struct XcdBarrier {
    unsigned* bar; unsigned x;
    volatile LAS unsigned* st;
};

__device__ __forceinline__ XcdBarrier xcd_barrier_post(unsigned* bar, volatile LAS unsigned* st) {
    XcdBarrier b; b.bar = bar; b.x = xb_xcc_id(); b.st = st;
    if (threadIdx.x == 0) (void)xb_add(&bar[XB_XCNT(b.x)], 1u);
    return b;
}
__device__ __forceinline__ void xcd_barrier_complete(unsigned* bar, unsigned x, unsigned& nloc, unsigned& nx) {
    const unsigned G = gridDim.x * gridDim.y * gridDim.z;
    unsigned sum, cnt, mine, sp = 0u;
    for (;;) {
        sum = 0u; cnt = 0u; mine = 0u;
#pragma unroll
        for (unsigned j = 0; j < 16; ++j) { const unsigned c = xb_ld(&bar[XB_XCNT(j)]); sum += c; cnt += (c > 0u) ? 1u : 0u; mine = (j == x) ? c : mine; }
        if (sum == G) break;
        __builtin_amdgcn_s_sleep(1);
        if ((++sp & 255u) == 0u) { if (xb_ld(&bar[XB_TMO])) break; if (sp > XB_SPIN_CAP) { atomicAdd(&bar[XB_TMO], 1u); break; } }
    }
    nloc = mine > 0u ? mine : 1u; nx = cnt > 0u ? cnt : 1u;
}

__device__ __forceinline__ void xcd_barrier(const XcdBarrier& b) {
    asm volatile("s_waitcnt vmcnt(0)" ::: "memory");
    __syncthreads();
    if (threadIdx.x == 0) {
        unsigned* bar = b.bar;
        __builtin_amdgcn_s_waitcnt(0);
        unsigned nloc = b.st[0], nx = b.st[1];
        if (nloc == 0u) { xcd_barrier_complete(bar, b.x, nloc, nx); b.st[0] = nloc; b.st[1] = nx; }
        const unsigned old = xb_add(&bar[XB_XSUB(b.x)], 1u);
        const unsigned gen = old / nloc;
        if (old + 1u == (gen + 1u) * nloc) {
            __builtin_amdgcn_fence(__ATOMIC_RELEASE, "agent");
            asm volatile("s_waitcnt vmcnt(0)" ::: "memory");
            const unsigned og = xb_add(&bar[XB_TOP], 1u);
            const unsigned tg = og / nx;
            if (og + 1u == (tg + 1u) * nx) xb_add(&bar[XB_TOPGEN], 1u);
            else XB_SPIN(xb_ld(&bar[XB_TOPGEN]) == tg, bar);
            __builtin_amdgcn_fence(__ATOMIC_ACQUIRE, "agent");
            xb_add(&bar[XB_XGEN(b.x)], 1u);
            asm volatile("s_waitcnt vmcnt(0)" ::: "memory");
        } else {
            XB_SPIN(xb_ld(&bar[XB_XGEN(b.x)]) == gen, bar);
            __builtin_amdgcn_fence(__ATOMIC_ACQUIRE, "agent");
            asm volatile("s_waitcnt vmcnt(0)" ::: "memory");
        }
    }
    __syncthreads();
}

DI void gbar(unsigned* bar, unsigned& gen) {
  asm volatile("s_waitcnt vmcnt(0)" ::: "memory");
  __syncthreads();
  ++gen;
  if (threadIdx.x == 0) {
    __builtin_amdgcn_fence(__ATOMIC_RELEASE, "agent");
    asm volatile("s_waitcnt vmcnt(0)" ::: "memory");
    __hip_atomic_fetch_add(bar, 1u, __ATOMIC_RELAXED, __HIP_MEMORY_SCOPE_AGENT);
    const unsigned target = gen * gridDim.x;
    while (__hip_atomic_load(bar, __ATOMIC_RELAXED, __HIP_MEMORY_SCOPE_AGENT) < target) __builtin_amdgcn_s_sleep(1);
    __builtin_amdgcn_fence(__ATOMIC_ACQUIRE, "agent");
    asm volatile("s_waitcnt vmcnt(0)" ::: "memory");
  }
  __syncthreads();
}

DI void row_bk(int row, int& b, int& kpos) {
  if (row < NLAT) { b = row >> 13; kpos = row & (S_ - 1); }
  else { int r = row - NLAT; b = r >> 8; kpos = S_ + (r & (L_ - 1)); }
}

DI void phase0(const Params& p, char* lds) {
  const int tid = tid_();
  for (int u = bid_(); u < 384; u += gridDim.x) {
    const int layer = u / 96, chunk = u % 96;
    float* sl = (float*)lds; float* red = (float*)(lds + 12288);
    for (int idx = tid; idx < 3072; idx += NTHR) {
      int m = idx >> 10, k = idx & 1023;
      float v = m < 2 ? p.c[m * 1024 + k] : p.c_ctx[k];
      sl[idx] = v / (1.0f + expf(-v));
    }
    __syncthreads();
    const int cgp = tid & 15, ks = tid >> 4, col = chunk * 64 + cgp * 4;
    f32x4 a0 = {0, 0, 0, 0}, a1 = a0, a2 = a0;
    const float* wp = p.ada_w + ((size_t)layer * 1024 + ks * 32) * 6144 + col;
#pragma unroll 8
    for (int kk = 0; kk < 32; ++kk) {
      f32x4 w = *(const f32x4*)(wp + (size_t)kk * 6144);
      int k = ks * 32 + kk;
      a0 += w * sl[k]; a1 += w * sl[1024 + k]; a2 += w * sl[2048 + k];
    }
    *(f32x4*)(red + (ks * 3 + 0) * 64 + cgp * 4) = a0;
    *(f32x4*)(red + (ks * 3 + 1) * 64 + cgp * 4) = a1;
    *(f32x4*)(red + (ks * 3 + 2) * 64 + cgp * 4) = a2;
    __syncthreads();
    if (tid < 192) {
      int m = tid >> 6, cc = tid & 63;
      float s = p.ada_b[layer * 6144 + chunk * 64 + cc];
#pragma unroll
      for (int k2 = 0; k2 < 32; ++k2) s += red[(k2 * 3 + m) * 64 + cc];
      p.mod[(layer * 3 + m) * 6144 + chunk * 64 + cc] = s;
    }
    __syncthreads();
  }
  {
    float* tile = (float*)lds;
    f32x4 cur[4], nxt[4];
    const int r_ = tid >> 5, c4_ = tid & 31;
    auto locate = [&](int u, WJob& jb, int& kt, int& nt) {
      int j = 0;
      while (j + 1 < p.njobs && u >= p.jobs[j + 1].tile0) ++j;
      jb = p.jobs[j];
      const int t = u - jb.tile0; kt = t / jb.ntn; nt = t % jb.ntn;
    };
    auto gload = [&](f32x4 (&dst)[4], const WJob& jb, int kt, int nt) {
#pragma unroll
      for (int i = 0; i < 4; ++i) {
        const int col = nt * 128 + c4_ * 4;
        dst[i] = (f32x4){0, 0, 0, 0};
        if (col < jb.N) dst[i] = *(const f32x4*)(jb.src + (size_t)(kt * 64 + r_ + 16 * i) * jb.N + col);
      }
    };
    int u = bid_();
    WJob jb; int kt = 0, nt = 0;
    if (u < p.ntiles_w) { locate(u, jb, kt, nt); gload(cur, jb, kt, nt); }
    while (u < p.ntiles_w) {
      const int un = u + (int)gridDim.x;
      WJob jbn = jb; int ktn = 0, ntn = 0;
      if (un < p.ntiles_w) { locate(un, jbn, ktn, ntn); gload(nxt, jbn, ktn, ntn); }
#pragma unroll
      for (int i = 0; i < 4; ++i) {
        float* d = tile + (r_ + 16 * i) * 129 + c4_ * 4;
        d[0] = cur[i][0]; d[1] = cur[i][1]; d[2] = cur[i][2]; d[3] = cur[i][3];
      }
      __syncthreads();
#pragma unroll
      for (int i = 0; i < 2; ++i) {
        const int idx = tid + NTHR * i, n = idx >> 3, kc = idx & 7;
        float v[8];
#pragma unroll
        for (int e = 0; e < 8; ++e) v[e] = tile[(kc * 8 + e) * 129 + n];
        u32x4 w; w.x = pk2(v[0], v[1]); w.y = pk2(v[2], v[3]); w.z = pk2(v[4], v[5]); w.w = pk2(v[6], v[7]);
        *(u32x4*)(jb.dst + (size_t)(nt * 128 + n) * jb.K + kt * 64 + kc * 8) = w;
      }
      __syncthreads();
#pragma unroll
      for (int i = 0; i < 4; ++i) cur[i] = nxt[i];
      jb = jbn; kt = ktn; nt = ntn; u = un;
    }
  }
  const size_t gtid = (size_t)bid_() * NTHR + tid, gsz = (size_t)gridDim.x * NTHR;
  for (size_t i = gtid; i < (size_t)512 * 256; i += gsz) ((f32x4*)p.xc)[i] = ((const f32x4*)p.ctx)[i];
  for (size_t i = gtid; i < (size_t)S_ * 24; i += gsz) {
    int t = (int)(i / 24), j = (int)(i % 24);
    float row = (float)(t >> 6), col = (float)(t & 63);
    float sr, cr, sc, cc;
    if (j < 16) {
      float f = p.freq64[j];
      sincos_d(row * f, sr, cr); sincos_d(col * f, sc, cc);
      float* d = p.rope64 + (size_t)t * 64;
      d[j] = cr; d[16 + j] = sr; d[32 + j] = cc; d[48 + j] = sc;
    } else {
      int jj = j - 16; float f = p.freq32[jj];
      sincos_d(row * f, sr, cr); sincos_d(col * f, sc, cc);
      float* d = p.rope32 + (size_t)t * 32;
      d[jj] = cr; d[8 + jj] = sr; d[16 + jj] = cc; d[24 + jj] = sc;
    }
  }
}

DI void modulate_phase(const Params& p, int layer, int which, int nrows, int nparts, const float* pgate) {
  const int lane = tid_() & 63, wid = tid_() >> 6;
  const float* gn = (which ? p.norm2_g : p.norm1_g) + layer * 1024;
  for (int row = bid_() * NWV + wid; row < nrows; row += gridDim.x * NWV) {
    const int m = row < S_ ? 0 : (row < NLAT ? 1 : 2);
    const float* xr = row < NLAT ? ((layer == 0 && which == 0) ? p.x : p.out) + (size_t)row * 1024 : p.xc + (size_t)(row - NLAT) * 1024;
    const float* md = p.mod + (layer * 3 + m) * 6144 + (which ? 3072 : 0);
    f32x4 v[4]; float ss = 0.f;
#pragma unroll
    for (int i = 0; i < 4; ++i) { v[i] = *(const f32x4*)(xr + i * 256 + lane * 4); ss += v[i][0] * v[i][0] + v[i][1] * v[i][1] + v[i][2] * v[i][2] + v[i][3] * v[i][3]; }
    if (nparts > 0 && row >= NLAT) {
      ss = 0.f;
#pragma unroll
      for (int i = 0; i < 4; ++i) {
        const int c = i * 256 + lane * 4;
        f32x4 acc = {0.f, 0.f, 0.f, 0.f};
        for (int s2 = 0; s2 < nparts; ++s2) acc += *(const f32x4*)(p.part + ((size_t)s2 * 512 + (row - NLAT)) * 1024 + c);
        v[i] += *(const f32x4*)(pgate + c) * acc;
        *(f32x4*)(p.xc + (size_t)(row - NLAT) * 1024 + c) = v[i];
        ss += v[i][0] * v[i][0] + v[i][1] * v[i][1] + v[i][2] * v[i][2] + v[i][3] * v[i][3];
      }
    }
    ss = wave_sum(ss);
    const float rstd = rsqrtf(ss * (1.0f / 1024.0f) + EPS_);
#pragma unroll
    for (int i = 0; i < 4; ++i) {
      const int c = i * 256 + lane * 4;
      f32x4 g = *(const f32x4*)(gn + c), sh = *(const f32x4*)(md + c), sc = *(const f32x4*)(md + 1024 + c);
      f32x4 h = (v[i] * rstd * g) * (sc + 1.0f) + sh;
      u32x2 w; w.x = pk2(h[0], h[1]); w.y = pk2(h[2], h[3]);
      *(u32x2*)(p.H + (size_t)row * 1024 + c) = w;
    }
  }
}

namespace pg8 {
#define PG8_LAS __attribute__((address_space(3)))
typedef unsigned short bf16_t;
typedef short bf16x8 __attribute__((ext_vector_type(8)));
typedef float f32x4 __attribute__((ext_vector_type(4)));
typedef unsigned u32x4 __attribute__((ext_vector_type(4)));
constexpr int BM = 256, BK = 64, HALF = 128, HTB = HALF * BK * 2  , STAGE_BYTES = 8 * HTB, NXCD = 8, WGM = 8;

__host__ __device__ __forceinline__ int lds_byte(int r, int c) { const int st = (r >> 4) * 2 + (c >> 5), rr = r & 15, cc = c & 31, ob = rr * 64 + cc * 2; return st * 1024 + (ob ^ (((ob >> 9) & 1) << 5)); }
__host__ __device__ __forceinline__ void stage_rc(int b, int& R, int& C) { const int st = b / 1024, sb = b % 1024, swz = sb ^ (((sb >> 9) & 1) << 5); R = (st >> 1) * 16 + swz / 64; C = (st & 1) * 32 + (swz % 64) / 2; }
__host__ __device__ __forceinline__ int perm32(int rho) { const int n = rho >> 4, i = rho & 15; return 8 * (i >> 2) + 4 * n + (i & 3); }

struct Unit { int pm, pn; };
struct Gemm { const bf16_t* A; const bf16_t* Bt; int M, N, K, ld; };

struct StaticOrder {
    int nM, nN, nwg, G, c;
    __host__ __device__ void init(int M, int N, int G_, int c_) { nM = M / BM; nN = N / BM; nwg = nM * nN; G = G_; c = c_; }
    __host__ __device__ bool next(int i, Unit& u) const {
        const long L = (long)i * G + c; if (L >= nwg) return false;
        int wgid = (int)L; { const int q = nwg / NXCD, r = nwg % NXCD, xcd = wgid % NXCD, off = wgid / NXCD; wgid = (xcd < r ? xcd * (q + 1) : r * (q + 1) + (xcd - r) * q) + off; }
        const int nig = WGM * nN, gid = wgid / nig, fm = gid * WGM, gsz = (nM - fm) < WGM ? (nM - fm) : WGM;
        u.pm = fm + ((wgid % nig) % gsz); u.pn = (wgid % nig) / gsz; return true;
    }
    __device__ __forceinline__ void a_ready(const Unit&) const {}
    __device__ __forceinline__ void done(const Unit&) const {}
};


typedef float f32x4v __attribute__((ext_vector_type(4)));
template <int ACT> struct EpiStore {
    static constexpr bool PERM = true, AFTER_DRAIN = false;
    bf16_t* O; int ldc;
    __device__ __forceinline__ void operator()(const f32x4 (&acc)[2][2][4][2], const Unit& u, int wr, int wc, int fr, int fq) const {
        const int row0 = u.pm * BM + wr * 64 + fr, col0 = u.pn * BM + wc * 32 + 8 * fq;
#pragma unroll
        for (int ai = 0; ai < 2; ++ai)
#pragma unroll
            for (int m = 0; m < 4; ++m) { bf16_t* rowp = O + (size_t)(row0 + ai * HALF + m * 16) * ldc + col0;
#pragma unroll
                for (int bj = 0; bj < 2; ++bj) { f32x4 v0 = acc[ai][bj][m][0], v1 = acc[ai][bj][m][1];
                    if (ACT == 2) {
#pragma unroll
                        for (int e = 0; e < 4; ++e) { float a = v0[e] > 0.f ? v0[e] : 0.f; v0[e] = a * a; float b = v1[e] > 0.f ? v1[e] : 0.f; v1[e] = b * b; } }
                    u32x4 w; w.x = ::pk2(v0[0], v0[1]); w.y = ::pk2(v0[2], v0[3]); w.z = ::pk2(v1[0], v1[1]); w.w = ::pk2(v1[2], v1[3]);
                    *(u32x4*)(rowp + bj * HALF) = w; } }
    }
};
struct EpiPartial {
    static constexpr bool PERM = false, AFTER_DRAIN = false;
    float* part;
    __device__ __forceinline__ void operator()(const f32x4 (&acc)[2][2][4][2], const Unit& u, int wr, int wc, int fr, int fq) const {
        const int col0 = u.pn * BM + wc * 32 + 4 * fq;
#pragma unroll
        for (int ai = 0; ai < 2; ++ai)
#pragma unroll
            for (int m = 0; m < 4; ++m) { float* pr = part + (size_t)(u.pm * BM + ai * HALF + wr * 64 + m * 16 + fr) * 1024 + col0;
#pragma unroll
                for (int bj = 0; bj < 2; ++bj)
#pragma unroll
                    for (int n = 0; n < 2; ++n) *(f32x4*)(pr + bj * HALF + n * 16) = acc[ai][bj][m][n]; }
    }
};
struct EpiRes {
    static constexpr bool PERM = false, AFTER_DRAIN = false;
    const float* xsrc; float* xlat; float* xctx; const float* gate_base;
    __device__ __forceinline__ void operator()(const f32x4 (&acc)[2][2][4][2], const Unit& u, int wr, int wc, int fr, int fq) const {
        const int mi = u.pm < 32 ? 0 : (u.pm < 64 ? 1 : 2);
        const float* gate = gate_base + mi * 6144;
        const int col0 = u.pn * BM + wc * 32 + 4 * fq;
        f32x4 gv[2][2];
#pragma unroll
        for (int bj = 0; bj < 2; ++bj)
#pragma unroll
            for (int n = 0; n < 2; ++n) gv[bj][n] = *(const f32x4*)(gate + col0 + bj * HALF + n * 16);
#pragma unroll
        for (int ai = 0; ai < 2; ++ai)
#pragma unroll
            for (int m = 0; m < 4; ++m) { const int r = u.pm * BM + ai * HALF + wr * 64 + m * 16 + fr;
                float* xr = r < ::NLAT ? xlat + (size_t)r * 1024 : xctx + (size_t)(r - ::NLAT) * 1024;
                const float* xs = r < ::NLAT ? xsrc + (size_t)r * 1024 : xr;
#pragma unroll
                for (int bj = 0; bj < 2; ++bj)
#pragma unroll
                    for (int n = 0; n < 2; ++n) { const int cc = col0 + bj * HALF + n * 16; f32x4 xv = *(const f32x4*)(xs + cc); xv += gv[bj][n] * acc[ai][bj][m][n]; *(f32x4*)(xr + cc) = xv; } }
    }
};
template <class Epi, class Sched, bool ALIGN_EPI = false, bool SP2 = false>
__device__ __forceinline__ void gemm_phase(PG8_LAS unsigned char* lds, const Gemm g, const Sched& S, const Epi& E) {
    const int tid = ::tid_(), wid = __builtin_amdgcn_readfirstlane(tid >> 6), lane = tid & 63, wr = wid >> 2, wc = wid & 3, fr = lane & 15, fq = lane >> 4;
    const int K = g.ld, nt = g.K / BK;
    unsigned voffA[2], voffB[2];
#pragma unroll
    for (int i = 0; i < 2; ++i) { int R, C; stage_rc(tid * 16 + i * 8192, R, C); const int Rb = Epi::PERM ? ((R & ~31) + perm32(R & 31)) : R;
        voffA[i] = (unsigned)(R * K + C) * 2u; voffB[i] = (unsigned)(Rb * K + C) * 2u; }
    const size_t kstep = (size_t)(BK * 2);
    const size_t hstep = (size_t)HALF * K * 2;
    const size_t tstep = 2 * hstep;
    const unsigned ldsw = (unsigned)wid * 1024u;
    const int aoff = lds_byte(wr * 64 + fr, fq * 8), boff = lds_byte(wc * 32 + fr, fq * 8);
#define PG8_SA(b, h) (((b) * 2 + (h)) * HTB)
#define PG8_SB(b, h) ((4 + (b) * 2 + (h)) * HTB)
#define PG8_STAGE(bufoff, gbase, voff) do { _Pragma("unroll") for (int _i = 0; _i < 2; ++_i) \
        __builtin_amdgcn_global_load_lds((const unsigned*)((const char*)(gbase) + (voff)[_i]), (PG8_LAS unsigned*)(lds + (bufoff) + ldsw + _i * 8192), 16, 0, 0); } while (0)
#define PG8_LDA(dst, b, h) do { _Pragma("unroll") for (int m = 0; m < 4; ++m) _Pragma("unroll") for (int k = 0; k < 2; ++k) dst[m][k] = *(const PG8_LAS bf16x8*)(lds + PG8_SA(b, h) + aoff + m * 2048 + k * 1024); } while (0)
#define PG8_LDB(dst, b, h) do { _Pragma("unroll") for (int n = 0; n < 2; ++n) _Pragma("unroll") for (int k = 0; k < 2; ++k) dst[n][k] = *(const PG8_LAS bf16x8*)(lds + PG8_SB(b, h) + boff + n * 2048 + k * 1024); } while (0)
#define PG8_MMA(ai, bj, At, Bt) do { __builtin_amdgcn_s_setprio(1); _Pragma("unroll") for (int m = 0; m < 4; ++m) _Pragma("unroll") for (int n = 0; n < 2; ++n) _Pragma("unroll") for (int k = 0; k < 2; ++k) \
        acc[ai][bj][m][n] = __builtin_amdgcn_mfma_f32_16x16x32_bf16(Bt[n][k], At[m][k], acc[ai][bj][m][n], 0, 0, 0); __builtin_amdgcn_s_setprio(0); } while (0)
#define PG8_WAIT_V(n) asm volatile("s_waitcnt vmcnt(" #n ")" ::: "memory")
#define PG8_WAIT_L(n) asm volatile("s_waitcnt lgkmcnt(" #n ")" ::: "memory")
#define PG8_BAR __builtin_amdgcn_s_barrier()
#define PG8_SCHED __builtin_amdgcn_sched_barrier(0)
    Unit cur, nxt; int ui = 0;
    if (!S.next(0, cur)) return;
    f32x4 acc[2][2][4][2];
#pragma unroll
    for (int a = 0; a < 2; ++a)
#pragma unroll
        for (int b = 0; b < 2; ++b)
#pragma unroll
            for (int m = 0; m < 4; ++m)
#pragma unroll
                for (int n = 0; n < 2; ++n) acc[a][b][m][n] = (f32x4){0.f, 0.f, 0.f, 0.f};
    bf16x8 At[4][2], B0[2][2], B1[2][2];
    const char* cA = (const char*)g.A + (size_t)cur.pm * tstep; const char* cB = (const char*)g.Bt + (size_t)cur.pn * tstep;
    S.a_ready(cur);
    if constexpr (SP2) {
        PG8_STAGE(PG8_SB(0, 0), cB, voffB); PG8_STAGE(PG8_SB(0, 1), cB + hstep, voffB); PG8_STAGE(PG8_SA(0, 0), cA, voffA); PG8_STAGE(PG8_SA(0, 1), cA + hstep, voffA);
        if (wr == 1) PG8_BAR;
        PG8_WAIT_V(2); PG8_BAR;
        PG8_STAGE(PG8_SB(1, 0), cB + kstep, voffB); PG8_STAGE(PG8_SA(1, 0), cA + kstep, voffA); PG8_STAGE(PG8_SB(1, 1), cB + hstep + kstep, voffB);
        PG8_WAIT_V(6); PG8_BAR;
    } else {
        PG8_STAGE(PG8_SB(0, 0), cB, voffB); PG8_STAGE(PG8_SA(0, 0), cA, voffA); PG8_STAGE(PG8_SB(0, 1), cB + hstep, voffB); PG8_STAGE(PG8_SA(0, 1), cA + hstep, voffA);
        if (wr == 1) PG8_BAR;
        PG8_WAIT_V(4); PG8_BAR;
        PG8_STAGE(PG8_SB(1, 0), cB + kstep, voffB); PG8_STAGE(PG8_SA(1, 0), cA + kstep, voffA); PG8_STAGE(PG8_SB(1, 1), cB + hstep + kstep, voffB);
        PG8_WAIT_V(6); PG8_BAR;
    }
    for (;;) {
        const bool has_next = S.next(ui + 1, nxt);
        const char* nA = has_next ? (const char*)g.A + (size_t)nxt.pm * tstep : cA; const char* nB = has_next ? (const char*)g.Bt + (size_t)nxt.pn * tstep : cB;
        for (int t = 0; t < nt; t += 2) {
            const bool last = (t == nt - 2);
            const char* a1 = cA + (size_t)(t + 1) * kstep;
            const char* a2 = last ? nA : cA + (size_t)(t + 2) * kstep; const char* b2 = last ? nB : cB + (size_t)(t + 2) * kstep;
            const char* a3 = a2 + kstep; const char* b3 = b2 + kstep;
            if (last && has_next) S.a_ready(nxt);
            if constexpr (SP2) {
            PG8_LDB(B0, 0, 0); PG8_LDB(B1, 0, 1); PG8_SCHED; PG8_LDA(At, 0, 0); PG8_STAGE(PG8_SA(1, 1), a1 + hstep, voffA);
            PG8_WAIT_V(8); PG8_WAIT_L(0); PG8_BAR; PG8_MMA(0, 0, At, B0); PG8_MMA(0, 1, At, B1); PG8_BAR; PG8_SCHED;
            PG8_LDA(At, 0, 1); PG8_STAGE(PG8_SB(0, 0), b2, voffB); PG8_STAGE(PG8_SB(0, 1), b2 + hstep, voffB); PG8_STAGE(PG8_SA(0, 0), a2, voffA);
            PG8_WAIT_V(8); PG8_WAIT_L(0); PG8_BAR; PG8_MMA(1, 0, At, B0); PG8_MMA(1, 1, At, B1); PG8_BAR; PG8_SCHED;
            PG8_LDB(B0, 1, 0); PG8_LDB(B1, 1, 1); PG8_SCHED; PG8_LDA(At, 1, 0); PG8_STAGE(PG8_SA(0, 1), a2 + hstep, voffA);
            PG8_WAIT_V(8); PG8_WAIT_L(0); PG8_BAR; PG8_MMA(0, 0, At, B0); PG8_MMA(0, 1, At, B1); PG8_BAR; PG8_SCHED;
            PG8_LDA(At, 1, 1); PG8_STAGE(PG8_SB(1, 0), b3, voffB); PG8_STAGE(PG8_SB(1, 1), b3 + hstep, voffB); PG8_STAGE(PG8_SA(1, 0), a3, voffA);
            PG8_WAIT_V(8); PG8_WAIT_L(0); PG8_BAR; PG8_MMA(1, 0, At, B0); PG8_MMA(1, 1, At, B1); PG8_BAR; PG8_SCHED;
            } else {
            PG8_LDB(B0, 0, 0); PG8_SCHED; PG8_LDA(At, 0, 0); PG8_STAGE(PG8_SA(1, 1), a1 + hstep, voffA);
            PG8_WAIT_L(8); PG8_BAR; PG8_WAIT_L(0); PG8_MMA(0, 0, At, B0); PG8_BAR; PG8_SCHED;
            PG8_LDB(B1, 0, 1); PG8_STAGE(PG8_SB(0, 0), b2, voffB);
            PG8_BAR; PG8_WAIT_L(0); PG8_MMA(0, 1, At, B1); PG8_BAR;
            PG8_LDA(At, 0, 1); PG8_STAGE(PG8_SA(0, 0), a2, voffA);
            PG8_BAR; PG8_WAIT_L(0); PG8_MMA(1, 0, At, B0); PG8_BAR; PG8_SCHED;
            PG8_STAGE(PG8_SB(0, 1), b2 + hstep, voffB);
            PG8_WAIT_V(6); PG8_BAR; PG8_MMA(1, 1, At, B1); PG8_BAR;
            PG8_LDB(B0, 1, 0); PG8_SCHED; PG8_LDA(At, 1, 0); PG8_STAGE(PG8_SA(0, 1), a2 + hstep, voffA);
            PG8_WAIT_L(8); PG8_BAR; PG8_WAIT_L(0); PG8_MMA(0, 0, At, B0); PG8_BAR; PG8_SCHED;
            PG8_LDB(B1, 1, 1); PG8_STAGE(PG8_SB(1, 0), b3, voffB);
            PG8_BAR; PG8_WAIT_L(0); PG8_MMA(0, 1, At, B1); PG8_BAR;
            PG8_LDA(At, 1, 1); PG8_STAGE(PG8_SA(1, 0), a3, voffA);
            PG8_BAR; PG8_WAIT_L(0); PG8_MMA(1, 0, At, B0); PG8_BAR; PG8_SCHED;
            PG8_STAGE(PG8_SB(1, 1), b3 + hstep, voffB);
            PG8_WAIT_V(6); PG8_BAR; PG8_MMA(1, 1, At, B1); PG8_BAR;
            }
        }
        if constexpr (ALIGN_EPI) { if (wr == 0) PG8_BAR; }
        if constexpr (!Epi::AFTER_DRAIN) { E(acc, cur, wr, wc, fr, fq); S.done(cur); }
        if (!has_next) break;
#pragma unroll
        for (int a = 0; a < 2; ++a)
#pragma unroll
            for (int b = 0; b < 2; ++b)
#pragma unroll
                for (int m = 0; m < 4; ++m)
#pragma unroll
                    for (int n = 0; n < 2; ++n) acc[a][b][m][n] = (f32x4){0.f, 0.f, 0.f, 0.f};
        cur = nxt; cA = nA; cB = nB; ++ui;
        if constexpr (ALIGN_EPI) { if (wr == 1) PG8_BAR; }
    }
    PG8_WAIT_V(0);
    if constexpr (!ALIGN_EPI) { if (wr == 0) PG8_BAR; }
    PG8_BAR;
    if constexpr (Epi::AFTER_DRAIN) { E.fused(acc, cur, wr, wc, fr, fq, lds, wid, lane); S.done(cur); }
#undef PG8_SA
#undef PG8_SB
#undef PG8_STAGE
#undef PG8_LDA
#undef PG8_LDB
#undef PG8_MMA
#undef PG8_WAIT_V
#undef PG8_WAIT_L
#undef PG8_BAR
#undef PG8_SCHED
}
}

DI void transpose_chunk(char* lds, const bf16_t* src_row0, int ld, int colA, int colB, bf16_t* dst  ) {
  const int tid = tid_();
#pragma unroll
  for (int i = 0; i < 2; ++i) {
    int idx = tid + NTHR * i, tok = idx >> 4, ch = idx & 15;
    int col = ch < 8 ? colA + ch * 8 : colB + (ch - 8) * 8;
    u32x4 v = *(const u32x4*)(src_row0 + (size_t)tok * ld + col);
    *(u32x4*)(lds + tok * 272 + ch * 16) = v;
  }
  __syncthreads();
#pragma unroll
  for (int i = 0; i < 2; ++i) {
    int idx = tid + NTHR * i, col = idx >> 3, pc = idx & 7;
    unsigned short v[8];
#pragma unroll
    for (int j = 0; j < 8; ++j) { int tl = 16 * (pc >> 1) + 8 * (j >> 2) + 4 * (pc & 1) + (j & 3); v[j] = *(const unsigned short*)(lds + tl * 272 + col * 2); }
    u32x4 w; w.x = v[0] | ((unsigned)v[1] << 16); w.y = v[2] | ((unsigned)v[3] << 16); w.z = v[4] | ((unsigned)v[5] << 16); w.w = v[6] | ((unsigned)v[7] << 16);
    *(u32x4*)(dst + (size_t)col * KV_ + pc * 8) = w;
  }
  __syncthreads();
}

DI void unpack8(u32x4 r, float (&v)[8]) { v[0] = lo2f(r.x); v[1] = hi2f(r.x); v[2] = lo2f(r.y); v[3] = hi2f(r.y); v[4] = lo2f(r.z); v[5] = hi2f(r.z); v[6] = lo2f(r.w); v[7] = hi2f(r.w); }
DI u32x4 pack8(const float (&v)[8]) { u32x4 w; w.x = pk2(v[0], v[1]); w.y = pk2(v[2], v[3]); w.z = pk2(v[4], v[5]); w.w = pk2(v[6], v[7]); return w; }

DI void norm_rope64(float (&v)[8], const float* gain, int lane, bool rope, const float* tab  , float scale) {
  float ss = 0.f;
#pragma unroll
  for (int e = 0; e < 8; ++e) ss += v[e] * v[e];
  ss += __shfl_xor(ss, 1); ss += __shfl_xor(ss, 2); ss += __shfl_xor(ss, 4);
  const float rstd = rsqrtf(ss * (1.0f / 64.0f) + EPS_);
  const int sl = lane & 7;
  f32x4 g0 = *(const f32x4*)(gain + sl * 8), g1 = *(const f32x4*)(gain + sl * 8 + 4);
  v[0] *= rstd * g0[0]; v[1] *= rstd * g0[1]; v[2] *= rstd * g0[2]; v[3] *= rstd * g0[3];
  v[4] *= rstd * g1[0]; v[5] *= rstd * g1[1]; v[6] *= rstd * g1[2]; v[7] *= rstd * g1[3];
  float pr[8];
#pragma unroll
  for (int e = 0; e < 8; ++e) pr[e] = __shfl_xor(v[e], 2);
  if (rope) {
    const int base = (sl >> 2) * 32 + (sl & 1) * 8;
    const float sgn = (sl & 2) ? 1.0f : -1.0f;
    f32x4 c0 = *(const f32x4*)(tab + base), c1 = *(const f32x4*)(tab + base + 4), s0 = *(const f32x4*)(tab + base + 16), s1 = *(const f32x4*)(tab + base + 20);
#pragma unroll
    for (int e = 0; e < 4; ++e) { v[e] = v[e] * c0[e] + sgn * pr[e] * s0[e]; v[4 + e] = v[4 + e] * c1[e] + sgn * pr[4 + e] * s1[e]; }
  }
#pragma unroll
  for (int e = 0; e < 8; ++e) v[e] *= scale;
}

DI void post_even(const Params& p, char* lds, int i2) {
  const int tid = tid_(), lane = tid & 63, wid = tid >> 6;
  const float qscale = 0.125f * LOG2E;
  for (int row = bid_() * NWV + wid; row < NT; row += gridDim.x * NWV) {
    int b, kpos; row_bk(row, b, kpos);
    const bool lat = row < NLAT;
    const bf16_t* src = p.P + (size_t)row * 2304;
    const float* tab = p.rope64 + (size_t)(lat ? kpos : 0) * 64;
    const int l2 = lane & 15;
    const u32x4 r0 = *(const u32x4*)(src + lane * 8), r1 = *(const u32x4*)(src + 512 + lane * 8), r2 = *(const u32x4*)(src + 1536 + lane * 8), r3 = *(const u32x4*)(src + 2048 + l2 * 8);
    float v[8];
    unpack8(r0, v); norm_rope64(v, p.diff_q_g + i2 * 64, lane, lat, tab, qscale);
    *(u32x4*)(p.Q1 + (size_t)row * 512 + lane * 8) = pack8(v);
    unpack8(r1, v); norm_rope64(v, p.diff_k_g + i2 * 64, lane, lat, tab, 1.0f);
    *(u32x4*)(p.K1 + ((size_t)b * KV_ + kpos) * 512 + lane * 8) = pack8(v);
    unpack8(r2, v); norm_rope64(v, p.swa_q_g + i2 * 64, lane, lat, tab, qscale);
    *(u32x4*)(p.Q2 + (size_t)row * 512 + lane * 8) = pack8(v);
    unpack8(r3, v); norm_rope64(v, p.swa_k_g + i2 * 64, lane, lat, tab, 1.0f);
    if (lane < 16) *(u32x4*)(p.K2 + ((size_t)b * KV_ + kpos) * 128 + l2 * 8) = pack8(v);
  }
  for (int item = bid_(); item < (NT / 64) * 5; item += gridDim.x) {
    const int tile = item / 5, cch = item % 5;
    const int r0 = tile * 64; int b, kpos0; row_bk(r0, b, kpos0);
    const bf16_t* srow = p.P + (size_t)r0 * 2304;
    if (cch < 4) transpose_chunk(lds, srow, 2304, 1024 + cch * 128, 1024 + cch * 128 + 64, p.V1t + (size_t)(b * 512 + cch * 128) * KV_ + kpos0);
    else transpose_chunk(lds, srow, 2304, 2176, 2176 + 64, p.V2t + (size_t)(b * 128) * KV_ + kpos0);
  }
}

DI void post_odd_a(const Params& p, char* lds, int i2) {
  const int tid = tid_(), lane = tid & 63, wid = tid >> 6;
  const float qscale = 0.125f * LOG2E;
  for (int row = bid_() * NWV + wid; row < NT; row += gridDim.x * NWV) {
    int b, kpos; row_bk(row, b, kpos);
    const bf16_t* src = p.P + (size_t)row * 2560;
    const int l2 = lane & 31;
    const u32x4 r0 = *(const u32x4*)(src + lane * 8), r1 = *(const u32x4*)(src + 512 + l2 * 8), r2 = *(const u32x4*)(src + 800 + lane * 8), r3 = *(const u32x4*)(src + 1312 + lane * 8);
    u32x4 rk = {0, 0, 0, 0};
    if (lane >= 32 && lane < 36) rk = *(const u32x4*)(src + 768 + (lane - 32) * 8);
    float v[8];
    {
      unpack8(r0, v);
      float ss = 0.f;
#pragma unroll
      for (int e = 0; e < 8; ++e) ss += v[e] * v[e];
      ss = wave_sum(ss);
      const float rstd = rsqrtf(ss * (1.0f / 512.0f) + EPS_);
      const float* g = p.mla_qa_g + i2 * 512 + lane * 8;
#pragma unroll
      for (int e = 0; e < 8; ++e) v[e] *= rstd * g[e];
      *(u32x4*)(p.QAn + (size_t)row * 512 + lane * 8) = pack8(v);
    }
    {
      unpack8(r1, v);
      float ss = 0.f;
#pragma unroll
      for (int e = 0; e < 8; ++e) ss += v[e] * v[e];
#pragma unroll
      for (int o = 16; o >= 1; o >>= 1) ss += __shfl_xor(ss, o);
      const float rstd = rsqrtf(ss * (1.0f / 256.0f) + EPS_);
      const float* g = p.mla_kva_g + i2 * 256 + l2 * 8;
#pragma unroll
      for (int e = 0; e < 8; ++e) v[e] *= rstd * g[e];
      if (lane < 32) *(u32x4*)(p.KVAn + (size_t)row * 256 + l2 * 8) = pack8(v);
      else if (lane < 36) *(u32x4*)(p.KR + (size_t)row * 32 + (lane - 32) * 8) = rk;
    }
    unpack8(r2, v); norm_rope64(v, p.na_q_g + i2 * 64, lane, false, p.rope64, qscale);
    *(u32x4*)(p.Q2 + (size_t)row * 512 + lane * 8) = pack8(v);
    unpack8(r3, v); norm_rope64(v, p.na_k_g + i2 * 64, lane, false, p.rope64, 1.0f);
    *(u32x4*)(p.K2 + ((size_t)b * KV_ + kpos) * 512 + lane * 8) = pack8(v);
  }
  for (int item = bid_(); item < (NT / 64) * 4; item += gridDim.x) {
    const int tile = item >> 2, cch = item & 3;
    const int r0 = tile * 64; int b, kpos0; row_bk(r0, b, kpos0);
    const bf16_t* srow = p.P + (size_t)r0 * 2560;
    transpose_chunk(lds, srow, 2560, 1824 + cch * 128, 1824 + cch * 128 + 64, p.V2t + (size_t)(b * 512 + cch * 128) * KV_ + kpos0);
  }
}

DI void post_odd_c(const Params& p, char* lds, int i2) {
  const int tid = tid_(), lane = tid & 63, wid = tid >> 6;
  const float qscale = 0.10206207261596575f * LOG2E;
  const int sl = lane & 15, hg = lane >> 4;
  for (int row = bid_() * NWV + wid; row < NT; row += gridDim.x * NWV) {
    int b, kpos; row_bk(row, b, kpos);
    const bool lat = row < NLAT;
    u32x4 raw[4];
#pragma unroll
    for (int chunk = 0; chunk < 4; ++chunk) {
      const int head = (chunk & 1) * 4 + hg;
      raw[chunk] = (u32x4){0, 0, 0, 0};
      if (sl < 12) {
        if (chunk < 2) raw[chunk] = *(const u32x4*)(p.QUP + (size_t)row * 768 + head * 96 + sl * 8);
        else if (sl < 8) raw[chunk] = *(const u32x4*)(p.KVUP + (size_t)row * 1024 + head * 128 + sl * 8);
        else raw[chunk] = *(const u32x4*)(p.KR + (size_t)row * 32 + (sl - 8) * 8);
      }
    }
    f32x4 tc0 = {0, 0, 0, 0}, tc1 = tc0, ts0 = tc0, ts1 = tc0;
    const bool dorope = lat && sl >= 8 && sl < 12;
    if (dorope) { const float* tab = p.rope32 + (size_t)kpos * 32 + ((sl - 8) >> 1) * 16; tc0 = *(const f32x4*)tab; tc1 = *(const f32x4*)(tab + 4); ts0 = *(const f32x4*)(tab + 8); ts1 = *(const f32x4*)(tab + 12); }
#pragma unroll
    for (int chunk = 0; chunk < 4; ++chunk) {
      const int head = (chunk & 1) * 4 + hg;
      const bool isq = chunk < 2;
      float v[8];
      unpack8(raw[chunk], v);
      float ss = 0.f;
#pragma unroll
      for (int e = 0; e < 8; ++e) ss += v[e] * v[e];
      ss += __shfl_xor(ss, 1); ss += __shfl_xor(ss, 2); ss += __shfl_xor(ss, 4); ss += __shfl_xor(ss, 8);
      const float rstd = rsqrtf(ss * (1.0f / 96.0f) + EPS_);
      const float* g = (isq ? p.mla_q_g : p.mla_k_g) + i2 * 96 + (sl < 12 ? sl : 0) * 8;
#pragma unroll
      for (int e = 0; e < 8; ++e) v[e] *= rstd * g[e];
      float pr[8];
#pragma unroll
      for (int e = 0; e < 8; ++e) pr[e] = __shfl_xor(v[e], 1);
      if (dorope) {
        const float sgn = (sl & 1) ? 1.0f : -1.0f;
#pragma unroll
        for (int e = 0; e < 4; ++e) { v[e] = v[e] * tc0[e] + sgn * pr[e] * ts0[e]; v[4 + e] = v[4 + e] * tc1[e] + sgn * pr[4 + e] * ts1[e]; }
      }
      if (sl < 12) {
        if (isq) {
#pragma unroll
          for (int e = 0; e < 8; ++e) v[e] *= qscale;
          *(u32x4*)(p.Q1 + (size_t)row * 768 + head * 96 + sl * 8) = pack8(v);
        } else {
          *(u32x4*)(p.K1 + ((size_t)b * KV_ + kpos) * 768 + head * 96 + sl * 8) = pack8(v);
        }
      }
    }
  }
  for (int item = bid_(); item < (NT / 64) * 4; item += gridDim.x) {
    const int tile = item >> 2, cch = item & 3;
    const int r0 = tile * 64; int b, kpos0; row_bk(r0, b, kpos0);
    const bf16_t* srow = p.KVUP + (size_t)r0 * 1024;
    transpose_chunk(lds, srow, 1024, (2 * cch) * 128 + 64, (2 * cch + 1) * 128 + 64, p.V1t + (size_t)(b * 512 + cch * 128) * KV_ + kpos0);
  }
}

constexpr int ATT_STAGE = 31744;
template <int DQK, int DV, int MODE>
DI void attn_core(char* lds, const bf16_t* Qrow, const bf16_t* Kb, int ldk, const bf16_t* Vtb,
                  int t0a, int na, int t0b, int nb, int qpos, const float* rpbL, float bound,
                  f32x16 (&o)[DV / 32], float& l_out) {
  constexpr int KROW = DQK * 2 + 16, KCH = DQK / 8, NKCH = 64 * KCH, NKC = (NKCH + NTHR - 1) / NTHR, NVC = DV * 8 / NTHR, KS = DQK / 16, NDB = DV / 32;
  const int tid = tid_(), lane = tid & 63, l31 = lane & 31, hi = lane >> 5;
  bf16x8 qf[KS];
#pragma unroll
  for (int kk = 0; kk < KS; ++kk) qf[kk] = *(const bf16x8*)(Qrow + kk * 16 + hi * 8);
#pragma unroll
  for (int db = 0; db < NDB; ++db)
#pragma unroll
    for (int i = 0; i < 16; ++i) o[db][i] = 0.f;
  float l = 0.f;
  f32x16 negb;
#pragma unroll
  for (int i = 0; i < 16; ++i) negb[i] = -bound;
  asm volatile("" : "+v"(negb));
  u32x4 rk0[NKC], rv0[NVC], rk1[NKC], rv1[NVC];
  const int n = na + nb;
  int qrow = 0, qcol = 0, rs = 0, cs = 0;
  if (MODE == 2) { qrow = qpos >> 6; qcol = qpos & 63; rs = min(max(qrow - 4, 0), 120); cs = min(max(qcol - 8, 0), 48); }
  int kr_[NKC], kc_[NKC]; bool kok_[NKC];
#pragma unroll
  for (int i = 0; i < NKC; ++i) { int idx = tid + NTHR * i; kok_[i] = idx < NKCH; if (!kok_[i]) idx = 0; kr_[i] = idx / KCH; kc_[i] = idx % KCH; }
  const int vr_ = tid >> 3, vc_ = tid & 7;
#define ATT_TILE(s_) ((s_) < na ? t0a + (s_) : t0b + ((s_) - na))
#define ATT_GLOAD(RK, RV, kt_) do { \
    _Pragma("unroll") for (int i = 0; i < NKC; ++i) if (kok_[i]) RK[i] = *(const u32x4*)(Kb + (size_t)((kt_) * 64 + kr_[i]) * ldk + kc_[i] * 8); \
    _Pragma("unroll") for (int i = 0; i < NVC; ++i) RV[i] = *(const u32x4*)(Vtb + (size_t)(vr_ + 64 * i) * KV_ + (kt_) * 64 + vc_ * 8); } while (0)
#define ATT_LSTORE(RK, RV, base_) do { \
    _Pragma("unroll") for (int i = 0; i < NKC; ++i) if (kok_[i]) *(u32x4*)((base_) + kr_[i] * KROW + kc_[i] * 16) = RK[i]; \
    _Pragma("unroll") for (int i = 0; i < NVC; ++i) *(u32x4*)((base_) + 64 * KROW + (vr_ + 64 * i) * 144 + vc_ * 16) = RV[i]; } while (0)
  ATT_GLOAD(rk0, rv0, ATT_TILE(0));
  if (n > 1) ATT_GLOAD(rk1, rv1, ATT_TILE(1));
  ATT_LSTORE(rk0, rv0, lds);
  __syncthreads();
  auto step = [&](int s, u32x4 (&ldK)[NKC], u32x4 (&ldV)[NVC], u32x4 (&wrK)[NKC], u32x4 (&wrV)[NVC]) {
    const int kt = ATT_TILE(s);
    char* ldsK = lds + (s & 1) * ATT_STAGE; char* ldsV = ldsK + 64 * KROW;
    char* nx = lds + ((s + 1) & 1) * ATT_STAGE;
    if (s + 2 < n) ATT_GLOAD(ldK, ldV, ATT_TILE(s + 2));
    bool rowok = true; int dr = 0;
    if (MODE == 2) { rowok = (kt >= rs) && (kt < rs + 8); dr = kt - qrow + 7; }
    bool skip = false;
    if (MODE == 2) skip = (kt < 128) && !rowok;
    if (MODE == 1) { const int qmin = qpos - l31; skip = (kt < 128) && ((kt * 64 + 63 < qmin - 128) || (kt * 64 > qmin + 31 + 128)); }
    skip = __builtin_amdgcn_readfirstlane((int)skip) != 0;
    if (!skip)
#pragma unroll
    for (int sub = 0; sub < 2; ++sub) {
      f32x16 sa;
#pragma unroll
      for (int kk = 0; kk < KS; ++kk) {
        bf16x8 kf = *(const bf16x8*)(ldsK + (sub * 32 + l31) * KROW + kk * 32 + hi * 16);
        if (kk == 0) sa = mfma32(kf, qf[kk], negb); else sa = mfma32(kf, qf[kk], sa);
      }
      if (MODE == 1) {
        if (kt < 128) {
#pragma unroll
          for (int i = 0; i < 16; ++i) {
            const int kpos = kt * 64 + sub * 32 + (i & 3) + 8 * (i >> 2) + 4 * hi;
            const int d = kpos - qpos;
            if (d > 128 || d < -128) sa[i] = -INFINITY;
          }
        }
      } else if (MODE == 2) {
        if (kt < 128) {
#pragma unroll
          for (int i = 0; i < 16; ++i) {
            const int kcol = sub * 32 + (i & 3) + 8 * (i >> 2) + 4 * hi;
            const bool ok = rowok && (kcol >= cs) && (kcol < cs + 16);
            const int idx = ok ? dr * 31 + (kcol - qcol + 15) : 0;
            const float bias = rpbL[idx];
            sa[i] = ok ? sa[i] + bias : -INFINITY;
          }
        }
      }
      f32x2 rs2 = {0.f, 0.f};
#pragma unroll
      for (int i = 0; i < 16; i += 2) { f32x2 pv = {ex2(sa[i]), ex2(sa[i + 1])}; sa[i] = pv[0]; sa[i + 1] = pv[1]; rs2 += pv; }
      l += rs2[0] + rs2[1];
      bf16x8 pf[2];
#pragma unroll
      for (int j = 0; j < 2; ++j) {
        u32x4 w;
        w.x = pk2(sa[8 * j + 0], sa[8 * j + 1]); w.y = pk2(sa[8 * j + 2], sa[8 * j + 3]);
        w.z = pk2(sa[8 * j + 4], sa[8 * j + 5]); w.w = pk2(sa[8 * j + 6], sa[8 * j + 7]);
        pf[j] = __builtin_bit_cast(bf16x8, w);
      }
#pragma unroll
      for (int db = 0; db < NDB; ++db)
#pragma unroll
        for (int j = 0; j < 2; ++j) {
          bf16x8 vf = *(const bf16x8*)(ldsV + (db * 32 + l31) * 144 + (sub * 32 + j * 16 + hi * 8) * 2);
          o[db] = mfma32(vf, pf[j], o[db]);
        }
    }
    if (s + 1 < n) ATT_LSTORE(wrK, wrV, nx);
    __syncthreads();
  };
  for (int s = 0; s < n; s += 2) {
    step(s, rk0, rv0, rk1, rv1);
    if (s + 1 < n) step(s + 1, rk1, rv1, rk0, rv0);
  }
#undef ATT_TILE
#undef ATT_GLOAD
#undef ATT_LSTORE
  l_out = l + __shfl_xor(l, 32);
}

DI float logit_bound(const float* gq, const float* gk, int d, float scale) {
  const int lane = tid_() & 63;
  float a = fabsf(gq[lane]), b = fabsf(gk[lane]);
  if (d > 64 && lane < d - 64) { a = fmaxf(a, fabsf(gq[64 + lane])); b = fmaxf(b, fabsf(gk[64 + lane])); }
#pragma unroll
  for (int o = 32; o >= 1; o >>= 1) { a = fmaxf(a, __shfl_xor(a, o)); b = fmaxf(b, __shfl_xor(b, o)); }
  return (float)d * a * b * scale * LOG2E * 1.02f + 0.25f;
}

template <int NDB>
DI void store_o(bf16_t* dst, const f32x16 (&o)[NDB], float sc, int hi) {
#pragma unroll
  for (int db = 0; db < NDB; ++db)
#pragma unroll
    for (int g = 0; g < 4; ++g) {
      u32x2 w; w.x = pk2(o[db][4 * g] * sc, o[db][4 * g + 1] * sc); w.y = pk2(o[db][4 * g + 2] * sc, o[db][4 * g + 3] * sc);
      *(u32x2*)(dst + db * 32 + 8 * g + 4 * hi) = w;
    }
}

DI void unit_A(const Params& p, char* lds, int layer, int b, int h, int qrow0, int t0a, int na, int t0b, int nb) {
  const int i2 = layer >> 1;
  const int tid = tid_(), lane = tid & 63, wid = tid >> 6, l31 = lane & 31, hi = lane >> 5;
  const int qrow = qrow0 + wid * 32 + l31;
  const bf16_t* Vtb = p.V1t + (size_t)(b * 512 + h * 128) * KV_;
  f32x16 o0[4]; float l0;
  const float bound = logit_bound(p.diff_q_g + i2 * 64, p.diff_k_g + i2 * 64, 64, 0.125f);
  f32x4* sp = (f32x4*)(p.spill + ((size_t)bid_() * NTHR + tid) * 64);
  {
    attn_core<64, 128, 0>(lds, p.Q1 + (size_t)qrow * 512 + (h * 2 + 0) * 64, p.K1 + (size_t)b * KV_ * 512 + (h * 2 + 0) * 64, 512, Vtb, t0a, na, t0b, nb, 0, nullptr, bound, o0, l0);
    const float inv0 = 1.0f / l0;
#pragma unroll
    for (int db = 0; db < 4; ++db)
#pragma unroll
      for (int g = 0; g < 4; ++g) { f32x4 t = {o0[db][4 * g] * inv0, o0[db][4 * g + 1] * inv0, o0[db][4 * g + 2] * inv0, o0[db][4 * g + 3] * inv0}; sp[db * 4 + g] = t; }
  }
  attn_core<64, 128, 0>(lds, p.Q1 + (size_t)qrow * 512 + (h * 2 + 1) * 64, p.K1 + (size_t)b * KV_ * 512 + (h * 2 + 1) * 64, 512, Vtb, t0a, na, t0b, nb, 0, nullptr, bound, o0, l0);
  const float* lv = p.diff_lam + i2 * 256;
  float d01 = wave_sum(lv[lane] * lv[64 + lane]), d23 = wave_sum(lv[128 + lane] * lv[192 + lane]);
  const float lam_init = p.lam_init[layer];
  const float lam = expf(d01) - expf(d23) + lam_init;
  const float c1 = lam / l0;
  float ss = 0.f;
#pragma unroll
  for (int db = 0; db < 4; ++db)
#pragma unroll
    for (int g = 0; g < 4; ++g) { f32x4 t = sp[db * 4 + g];
#pragma unroll
      for (int e = 0; e < 4; ++e) { float d = t[e] - c1 * o0[db][4 * g + e]; o0[db][4 * g + e] = d; ss += d * d; } }
  ss += __shfl_xor(ss, 32);
  const float rstd = rsqrtf(ss * (1.0f / 128.0f) + EPS_) * (1.0f - lam_init);
  const float* sg = p.diff_subln_g + i2 * 128;
  bf16_t* dst = p.H + (size_t)qrow * 1024 + h * 128;
#pragma unroll
  for (int db = 0; db < 4; ++db)
#pragma unroll
    for (int g = 0; g < 4; ++g) {
      f32x4 gg = *(const f32x4*)(sg + db * 32 + 8 * g + 4 * hi);
      u32x2 w; w.x = pk2(o0[db][4 * g] * rstd * gg[0], o0[db][4 * g + 1] * rstd * gg[1]); w.y = pk2(o0[db][4 * g + 2] * rstd * gg[2], o0[db][4 * g + 3] * rstd * gg[3]);
      *(u32x2*)(dst + db * 32 + 8 * g + 4 * hi) = w;
    }
}

template <int DQK, int DV, int MODE>
DI void unit_S(const Params& p, char* lds, const bf16_t* Q, int ldq, int qcoloff, const bf16_t* Kb, int ldk, const bf16_t* Vtb,
               int qrow0, int t0a, int na, int t0b, int nb, int qpos0, const float* rpbL, float bound, bool has_sink, float sink2, int ocol) {
  const int tid = tid_(), lane = tid & 63, wid = tid >> 6, l31 = lane & 31, hi = lane >> 5;
  const int qrow = qrow0 + wid * 32 + l31;
  f32x16 o[DV / 32]; float l;
  attn_core<DQK, DV, MODE>(lds, Q + (size_t)qrow * ldq + qcoloff, Kb, ldk, Vtb, t0a, na, t0b, nb, qpos0 + wid * 32 + l31, rpbL, bound, o, l);
  if (has_sink) l += ex2(sink2 - bound);
  store_o<DV / 32>(p.H + (size_t)qrow * 1024 + ocol, o, 1.0f / l, hi);
}

DI void attn_even(const Params& p, char* lds, int layer, bool need_ctx) {
  const int i2 = layer >> 1;
  if ((tid_() >> 6) >= 4) __builtin_amdgcn_s_setprio(1);
  const int nunits = 256 + 512 + (need_ctx ? 24 : 0);
  for (int u = bid_(); u < nunits; u += gridDim.x) {
    const bool isA = (u < 256) || (u >= 768 && u < 776);
    if (isA) {
      int b, h, qrow0, t0, nt;
      if (u < 256) { const int bh = u & 7, qb = u >> 3; b = bh >> 2; h = bh & 3; qrow0 = b * S_ + qb * 256; t0 = 0; nt = 132; }
      else { const int v = u - 768; b = v >> 2; h = v & 3; qrow0 = NLAT + b * 256; t0 = 128; nt = 4; }
      unit_A(p, lds, layer, b, h, qrow0, t0, nt, 0, 0);
    } else {
      int b, hq, qrow0, ta, na, tb, nb, qpos0;
      if (u < 768) { const int v = u - 256, bh = v & 15, qb = v >> 4; b = bh >> 3; hq = bh & 7; qrow0 = b * S_ + qb * 256; qpos0 = qb * 256;
                     ta = max(0, 4 * qb - 2); na = min(128, 4 * qb + 6) - ta; tb = 128; nb = 4; }
      else { const int v = u - 776; b = v >> 3; hq = v & 7; qrow0 = NLAT + b * 256; qpos0 = 0; ta = 128; na = 4; tb = 0; nb = 0; }
      const int kvh = hq >> 2;
      unit_S<64, 64, 1>(p, lds, p.Q2, 512, hq * 64, p.K2 + (size_t)b * KV_ * 128 + kvh * 64, 128, p.V2t + (size_t)(b * 128 + kvh * 64) * KV_,
                        qrow0, ta, na, tb, nb, qpos0, nullptr, logit_bound(p.swa_q_g + i2 * 64, p.swa_k_g + i2 * 64, 64, 0.125f), true, p.swa_sink[i2 * 8 + hq] * LOG2E, 512 + hq * 64);
    }
  }
}

DI void attn_odd(const Params& p, char* lds, int layer, bool need_ctx) {
  const int i2 = layer >> 1;
  if ((tid_() >> 6) >= 4) __builtin_amdgcn_s_setprio(1);
  const int nunits = 512 + 512 + (need_ctx ? 32 : 0);
  float* rpbL = (float*)(lds + 65536);
  for (int u = bid_(); u < nunits; u += gridDim.x) {
    const bool isC = (u < 512) || (u >= 1024 && u < 1040);
    if (isC) {
      int b, h, qrow0, t0, nt;
      if (u < 512) { const int bh = (u & 7) + 8 * (u >> 8), qb = (u >> 3) & 31; b = bh >> 3; h = bh & 7; qrow0 = b * S_ + qb * 256; t0 = 0; nt = 132; }
      else { const int v = u - 1024; b = v >> 3; h = v & 7; qrow0 = NLAT + b * 256; t0 = 128; nt = 4; }
      unit_S<96, 64, 0>(p, lds, p.Q1, 768, h * 96, p.K1 + (size_t)b * KV_ * 768 + h * 96, 768, p.V1t + (size_t)(b * 512 + h * 64) * KV_,
                        qrow0, t0, nt, 0, 0, 0, nullptr, logit_bound(p.mla_q_g + i2 * 96, p.mla_k_g + i2 * 96, 96, 0.10206207261596575f), false, 0.f, h * 64);
    } else {
      int b, h, qrow0, ta, na, tb, nb, qpos0;
      if (u < 1024) { const int v = u - 512, bh = v & 15, qb = v >> 4; b = bh >> 3; h = bh & 7; qrow0 = b * S_ + qb * 256; qpos0 = qb * 256;
                      const int r0 = 4 * qb, r1 = 4 * qb + 3; ta = min(max(r0 - 4, 0), 120); na = min(max(r1 - 4, 0), 120) + 8 - ta; tb = 128; nb = 4; }
      else { const int v = u - 1040; b = v >> 3; h = v & 7; qrow0 = NLAT + b * 256; qpos0 = 0; ta = 128; na = 4; tb = 0; nb = 0; }
      for (int i = tid_(); i < 465; i += NTHR) rpbL[i] = p.na_rpb[(i2 * 8 + h) * 465 + i] * LOG2E;
      float bmax = 0.f;
      for (int i = tid_() & 63; i < 465; i += 64) bmax = fmaxf(bmax, fabsf(p.na_rpb[(i2 * 8 + h) * 465 + i]));
#pragma unroll
      for (int o2 = 32; o2 >= 1; o2 >>= 1) bmax = fmaxf(bmax, __shfl_xor(bmax, o2));
      __syncthreads();
      unit_S<64, 64, 2>(p, lds, p.Q2, 512, h * 64, p.K2 + (size_t)b * KV_ * 512 + h * 64, 512, p.V2t + (size_t)(b * 512 + h * 64) * KV_,
                        qrow0, ta, na, tb, nb, qpos0, rpbL, logit_bound(p.na_q_g + i2 * 64, p.na_k_g + i2 * 64, 64, 0.125f) + bmax * LOG2E, false, 0.f, 512 + h * 64);
    }
  }
}

template <class Epi>
DI void run_gemm(unsigned char* lds, const bf16_t* A, const bf16_t* Bt, int M, int N, int K, const Epi& E) {
  pg8::Gemm g{A, Bt, M, N, K, K};
  pg8::StaticOrder S; S.init(M, N, (int)gridDim.x, bid_());
  pg8::gemm_phase<Epi, pg8::StaticOrder, true, true>((PG8_LAS unsigned char*)lds, g, S, E);
}

template <int NS>
DI void run_gemm_ctx_splitk(unsigned char* lds, const Params& p, const bf16_t* A  , const bf16_t* Bt, int Kfull) {
  const int G = (int)gridDim.x, c = bid_();
  const int slot = G - 1 - c;
  if (slot >= NS * 8) return;
  const int sl = slot >> 3, un = slot & 7;
  const int Kc = Kfull / NS;
  pg8::Gemm g{A + (size_t)NLAT * Kfull + (size_t)sl * Kc, Bt + (size_t)sl * Kc, 512, 1024, Kc, Kfull};
  pg8::StaticOrder S; S.init(512, 1024, 8, un);
  pg8::EpiPartial E{p.part + (size_t)sl * 512 * 1024};
  pg8::gemm_phase<pg8::EpiPartial, pg8::StaticOrder, true, true>((PG8_LAS unsigned char*)lds, g, S, E);
}

template <int layer>
DI void layer_body(const Params& p, char* lds, unsigned char* lds_u, const XcdBarrier& xbar) {

    const bool need_ctx = layer < 3;
    const int i2 = layer >> 1;
    const int m_res = need_ctx ? NT : NLAT;
    const float* modl = p.mod + layer * 3 * 6144;
    modulate_phase(p, layer, 0, NT, layer > 0 ? 8 : 0, p.mod + ((layer > 0 ? layer - 1 : 0) * 3 + 2) * 6144 + 5120);
    xcd_barrier(xbar);
    if ((layer & 1) == 0) {
      { pg8::EpiStore<0> E{p.P, 2304}; run_gemm(lds_u, p.H, p.wt_in[layer], NT, 2304, 1024, E); }
      xcd_barrier(xbar);
      post_even(p, lds, i2);
      xcd_barrier(xbar);
      attn_even(p, lds, layer, need_ctx);
      __builtin_amdgcn_s_setprio(0);
    } else {
      { pg8::EpiStore<0> E{p.P, 2560}; run_gemm(lds_u, p.H, p.wt_in[layer], NT, 2560, 1024, E); }
      xcd_barrier(xbar);
      post_odd_a(p, lds, i2);
      xcd_barrier(xbar);
      { pg8::EpiStore<0> E{p.QUP, 768}; run_gemm(lds_u, p.QAn, p.wt_qup[i2], NT, 768, 512, E); }
      { pg8::EpiStore<0> E{p.KVUP, 1024}; run_gemm(lds_u, p.KVAn, p.wt_kvup[i2], NT, 1024, 256, E); }
      xcd_barrier(xbar);
      post_odd_c(p, lds, i2);
      xcd_barrier(xbar);
      attn_odd(p, lds, layer, need_ctx);
      __builtin_amdgcn_s_setprio(0);
    }
    xcd_barrier(xbar);
    { pg8::EpiRes E{layer == 0 ? p.x : p.out, p.out, p.xc, modl + 2048}; run_gemm(lds_u, p.H, p.wt_out[layer], NLAT, 1024, 1024, E); }
    if (need_ctx) run_gemm_ctx_splitk<4>(lds_u, p, p.H, p.wt_out[layer], 1024);
    xcd_barrier(xbar);
    modulate_phase(p, layer, 1, m_res, need_ctx ? 4 : 0, modl + 2 * 6144 + 2048);
    xcd_barrier(xbar);
    { pg8::EpiStore<2> E{p.HID, 4096}; run_gemm(lds_u, p.H, p.wt_1[layer], m_res, 4096, 1024, E); }
    xcd_barrier(xbar);
    { pg8::EpiRes E{p.out, p.out, p.xc, modl + 5120}; run_gemm(lds_u, p.HID, p.wt_2[layer], NLAT, 1024, 4096, E); }
    if (need_ctx) run_gemm_ctx_splitk<8>(lds_u, p, p.HID, p.wt_2[layer], 4096);
    xcd_barrier(xbar);
  }
__global__ void __launch_bounds__(NTHR, 2) mega(Params p) {
  extern __shared__ __attribute__((aligned(16))) unsigned char lds_u[];
  char* lds = (char*)lds_u;
  cg::grid_group grid = cg::this_grid();
  volatile LAS unsigned* xst = (volatile LAS unsigned*)((LAS unsigned char*)lds_u + LDS_BYTES);
  if (threadIdx.x < 4) xst[threadIdx.x] = 0u;
  __syncthreads();
  const XcdBarrier xbar = xcd_barrier_post(p.bar, xst);
  phase0(p, lds);
  grid.sync();
  layer_body<0>(p, lds, lds_u, xbar);
  layer_body<1>(p, lds, lds_u, xbar);
  layer_body<2>(p, lds, lds_u, xbar);
  layer_body<3>(p, lds, lds_u, xbar);
}

extern "C" void kernel_launch(void* const* d_in, const int* in_sizes, int n_in, void* d_out, int out_size, void* d_ws, size_t ws_size, hipStream_t stream) {
  static int grid_blocks = 0;
  if (!grid_blocks) {
    int dev = 0, cus = 0, per_cu = 0;
    (void)hipGetDevice(&dev);
    (void)hipDeviceGetAttribute(&cus, hipDeviceAttributeMultiprocessorCount, dev);
    (void)hipFuncSetAttribute((const void*)mega, hipFuncAttributeMaxDynamicSharedMemorySize, LDS_BYTES + 16);
    (void)hipOccupancyMaxActiveBlocksPerMultiprocessor(&per_cu, (const void*)mega, NTHR, LDS_BYTES + 16);
    if (per_cu != 1) per_cu = 1;
    grid_blocks = cus * per_cu;
  }
  Params p{};
  const float** pin = (const float**)&p.x;
  for (int i = 0; i < 29; ++i) pin[i] = (const float*)d_in[i];
  p.out = (float*)d_out;
  char* w = (char*)d_ws;
  size_t off = 0;
  auto take = [&](size_t bytes) { char* r = w + off; off += (bytes + 255) & ~(size_t)255; return r; };
  p.bar = (unsigned*)take((size_t)XCD_BAR_WORDS * 4);
  p.xc = (float*)take((size_t)512 * 1024 * 4);
  p.mod = (float*)take((size_t)4 * 3 * 6144 * 4);
  p.rope64 = (float*)take((size_t)S_ * 64 * 4);
  p.rope32 = (float*)take((size_t)S_ * 32 * 4);
  for (int l = 0; l < 4; ++l) {
    p.wt_in[l] = (bf16_t*)take((size_t)2560 * 1024 * 2);
    p.wt_out[l] = (bf16_t*)take((size_t)1024 * 1024 * 2);
    p.wt_1[l] = (bf16_t*)take((size_t)4096 * 1024 * 2);
    p.wt_2[l] = (bf16_t*)take((size_t)4096 * 1024 * 2);
  }
  for (int i = 0; i < 2; ++i) { p.wt_qup[i] = (bf16_t*)take((size_t)768 * 512 * 2); p.wt_kvup[i] = (bf16_t*)take((size_t)1024 * 256 * 2); }
  p.part = (float*)take((size_t)8 * 512 * 1024 * 4);
  p.H = (bf16_t*)take((size_t)NT * 1024 * 2);
  p.KR = (bf16_t*)take((size_t)NT * 32 * 2);
  char* R = take(0);
  size_t roff = 0;
  auto rtake = [&](size_t bytes) { char* r = R + roff; roff += (bytes + 255) & ~(size_t)255; return r; };
  p.P = (bf16_t*)rtake((size_t)NT * 2560 * 2);
  p.Q1 = (bf16_t*)rtake((size_t)NT * 768 * 2);
  p.K1 = (bf16_t*)rtake((size_t)NT * 768 * 2);
  p.V1t = (bf16_t*)rtake((size_t)1024 * KV_ * 2);
  p.Q2 = (bf16_t*)rtake((size_t)NT * 512 * 2);
  p.K2 = (bf16_t*)rtake((size_t)NT * 512 * 2);
  p.V2t = (bf16_t*)rtake((size_t)1024 * KV_ * 2);
  p.HID = (bf16_t*)R;
  p.spill = (float*)p.P;
  p.QUP = p.P;
  p.KVUP = p.P + (size_t)NT * 768;
  p.QAn = p.H;
  p.KVAn = p.H + (size_t)NT * 512;
  int nj = 0, tiles = 0;
  auto add = [&](const float* src, bf16_t* dst, int K, int N, int Npad) {
    WJob& j = p.jobs[nj++]; j.src = src; j.dst = dst; j.K = K; j.N = N; j.Npad = Npad; j.tile0 = tiles; j.ntn = Npad / 128; j.pad_ = 0; tiles += (K / 64) * (Npad / 128);
  };
  for (int l = 0; l < 4; ++l) {
    const int i = l >> 1;
    if ((l & 1) == 0) add(p.ev_w_in + (size_t)i * 1024 * 2304, p.wt_in[l], 1024, 2304, 2304);
    else add(p.od_w_in + (size_t)i * 1024 * 2336, p.wt_in[l], 1024, 2336, 2560);
    add(p.w_out + (size_t)l * 1024 * 1024, p.wt_out[l], 1024, 1024, 1024);
    add(p.mlp_w1 + (size_t)l * 1024 * 4096, p.wt_1[l], 1024, 4096, 4096);
    add(p.mlp_w2 + (size_t)l * 4096 * 1024, p.wt_2[l], 4096, 1024, 1024);
    if (l & 1) {
      add(p.mla_wq_up + (size_t)i * 512 * 768, p.wt_qup[i], 512, 768, 768);
      add(p.mla_wkv_up + (size_t)i * 256 * 1024, p.wt_kvup[i], 256, 1024, 1024);
    }
  }
  p.njobs = nj; p.ntiles_w = tiles;
  for (int j = 0; j < 16; ++j) p.freq64[j] = powf(10000.0f, -(float)j / 16.0f);
  for (int j = 0; j < 8; ++j) p.freq32[j] = powf(10000.0f, -(float)j / 8.0f);
  for (int l = 0; l < 4; ++l) p.lam_init[l] = (float)(0.8 - 0.6 * exp(-0.3 * (double)l));
  (void)hipMemsetAsync(p.bar, 0, (size_t)XCD_BAR_WORDS * 4, stream);
  void* args[] = {&p};
  hipError_t e = hipLaunchCooperativeKernel((void*)mega, dim3(grid_blocks), dim3(NTHR), args, LDS_BYTES + 16, stream);
  if (e != hipSuccess) fprintf(stderr, "cooperative launch failed: %s (grid %d)\n", hipGetErrorString(e), grid_blocks);
}
```
